# Optimizing an MI355X kernel written in HIP

```python
import math
import jax, jax.numpy as jnp
from jax import lax
import numpy as np

D_MODEL = 2048
BATCH = 2
SEQ = 16384
DEPTH = 4

D_MIX = D_MODEL
ATTN_WIDTH = D_MIX // 2
ATTN_HD = 64
N_Q_HEADS = ATTN_WIDTH // ATTN_HD
N_KV_HEADS = N_Q_HEADS // 8
GQA_GROUP = N_Q_HEADS // N_KV_HEADS
WINDOW = 128
BLOCK = 128
GLA_WIDTH = D_MIX - ATTN_WIDTH
GLA_HEADS = 4
GLA_DV = GLA_WIDTH // GLA_HEADS
GLA_DK = GLA_DV // 2
GLA_RANK = 16
GLA_TAU = 16.0
GLA_CHUNK = 64
D_FF = ((8 * D_MODEL // 3 + 255) // 256) * 256
N_MOD = 9
EPS = 1e-6

kernel_name = "hybrid_swa_sink_alibi_gla_macaron_adaln"


def _split_sizes():
    return [N_Q_HEADS * ATTN_HD, N_KV_HEADS * ATTN_HD, N_KV_HEADS * ATTN_HD,
            GLA_HEADS * GLA_DK, GLA_HEADS * GLA_DK, GLA_HEADS * GLA_DV,
            GLA_HEADS * GLA_DV, GLA_RANK]


def _rmsnorm_mod(x, w, shift, scale):
    xf = x.astype(jnp.float32)
    y = xf * lax.rsqrt(jnp.mean(xf * xf, axis=-1, keepdims=True) + EPS) * w.astype(jnp.float32)
    y = y * (1.0 + scale.astype(jnp.float32)) + shift.astype(jnp.float32)
    return y.astype(x.dtype)


def _swiglu(h, w1, w3, w2):
    return (jax.nn.silu(h @ w1) * (h @ w3)) @ w2


def _alibi_slopes(n):
    return jnp.exp2(-8.0 * jnp.arange(1, n + 1, dtype=jnp.float32) / n)


def _swa_sink_attention(q, k, v, sinks):
    B, S, _ = q.shape
    nb = S // BLOCK
    q = q.reshape(B, nb, BLOCK, N_KV_HEADS, GQA_GROUP, ATTN_HD)

    def slab(t):
        t = t.reshape(B, S, N_KV_HEADS, ATTN_HD)
        t = jnp.pad(t, ((0, 0), (BLOCK, 0), (0, 0), (0, 0)))
        t = t.reshape(B, nb + 1, BLOCK, N_KV_HEADS, ATTN_HD)
        return jnp.concatenate([t[:, :-1], t[:, 1:]], axis=2)

    ks, vs = slab(k), slab(v)
    s = jnp.einsum('bnqkgd,bnskd->bnkgqs', q, ks).astype(jnp.float32) * (ATTN_HD ** -0.5)
    qi = jnp.arange(BLOCK)[:, None]
    kj = jnp.arange(2 * BLOCK)[None, :]
    dist = qi + BLOCK - kj
    band = (dist >= 0) & (dist < WINDOW)
    valid = band[None] & ((jnp.arange(nb) > 0)[:, None, None] | (kj >= BLOCK)[None])
    slopes = _alibi_slopes(N_Q_HEADS).reshape(N_KV_HEADS, GQA_GROUP)
    bias = -slopes[:, :, None, None] * dist.astype(jnp.float32)[None, None]
    s = jnp.where(valid[None, :, None, None], s + bias[None, None], -jnp.inf)
    sink = sinks.astype(jnp.float32).reshape(N_KV_HEADS, GQA_GROUP)[None, None, :, :, None, None]
    m = jnp.maximum(jnp.max(s, axis=-1, keepdims=True), sink)
    p = jnp.exp(s - m)
    p = p / (jnp.sum(p, axis=-1, keepdims=True) + jnp.exp(sink - m))
    o = jnp.einsum('bnkgqs,bnskd->bnqkgd', p.astype(vs.dtype), vs)
    return o.reshape(B, S, N_Q_HEADS * ATTN_HD)


def _gla(q, k, v, g, r, norm_w):
    B, S, _ = q.shape
    N = S // GLA_CHUNK
    out_dtype = v.dtype

    def chunks(t, d):
        return t.reshape(B, N, GLA_CHUNK, GLA_HEADS, d).transpose(0, 3, 1, 2, 4).astype(jnp.float32)

    q = chunks(q, GLA_DK) * (GLA_DK ** -0.5)
    k = chunks(k, GLA_DK)
    v = chunks(v, GLA_DV)
    b = jnp.cumsum(chunks(g, GLA_DK), axis=3)
    q_t = q * jnp.exp(b)
    k_t = k * jnp.exp(-b)
    causal = jnp.tril(jnp.ones((GLA_CHUNK, GLA_CHUNK), dtype=bool))
    a = jnp.where(causal, jnp.einsum('bhncd,bhnsd->bhncs', q_t, k_t), 0.0)
    o_intra = jnp.einsum('bhncs,bhnse->bhnce', a, v)
    b_last = b[:, :, :, -1:, :]
    k_end = k * jnp.exp(b_last - b)
    decay = jnp.exp(b_last[:, :, :, 0, :])

    def step(state, inp):
        qc, kc, vc, dc = inp
        o = jnp.einsum('bhcd,bhde->bhce', qc, state)
        state = dc[..., None] * state + jnp.einsum('bhcd,bhce->bhde', kc, vc)
        return state, o

    xs = (jnp.moveaxis(q_t, 2, 0), jnp.moveaxis(k_end, 2, 0), jnp.moveaxis(v, 2, 0), jnp.moveaxis(decay, 2, 0))
    s0 = jnp.zeros((B, GLA_HEADS, GLA_DK, GLA_DV), jnp.float32)
    _, o_inter = lax.scan(step, s0, xs)
    o = o_intra + jnp.moveaxis(o_inter, 0, 2)
    o = o.transpose(0, 2, 3, 1, 4).reshape(B, S, GLA_HEADS, GLA_DV)
    o = o * lax.rsqrt(jnp.mean(o * o, axis=-1, keepdims=True) + EPS) * norm_w.astype(jnp.float32)
    o = o.reshape(B, S, GLA_HEADS * GLA_DV) * jax.nn.silu(r.astype(jnp.float32))
    return o.astype(out_dtype)


def _mixer(h, w_in, gate_w2, gate_b, sinks, gla_norm, w_out):
    p = h @ w_in
    idx = list(np.cumsum(_split_sizes())[:-1])
    q_a, k_a, v_a, q_g, k_g, v_g, r_g, gate_lr = jnp.split(p, idx, axis=-1)
    g = jax.nn.log_sigmoid((gate_lr @ gate_w2 + gate_b).astype(jnp.float32)) / GLA_TAU
    o_attn = _swa_sink_attention(q_a, k_a, v_a, sinks)
    o_gla = _gla(q_g, k_g, v_g, g, r_g, gla_norm)
    return jnp.concatenate([o_attn, o_gla.astype(o_attn.dtype)], axis=-1) @ w_out


def setup_inputs(seed: int = 0) -> dict:
    key = jax.random.key(seed)
    ks = jax.random.split(key, 24)
    nrm = jax.random.normal
    f32 = jnp.float32
    n_in = sum(_split_sizes())
    L, D = DEPTH, D_MODEL
    return {
        "x": nrm(ks[0], (BATCH, SEQ, D), f32),
        "c": nrm(ks[1], (BATCH, D), f32),
        "ada_w": nrm(ks[2], (L, D, N_MOD * D), f32) * D ** -0.5,
        "ada_b": nrm(ks[3], (L, N_MOD * D), f32) * 0.01,
        "norm_ffn1": 1.0 + 0.05 * nrm(ks[4], (L, D), f32),
        "ffn1_w1": nrm(ks[5], (L, D, D_FF), f32) * D ** -0.5,
        "ffn1_w3": nrm(ks[6], (L, D, D_FF), f32) * D ** -0.5,
        "ffn1_w2": nrm(ks[7], (L, D_FF, D), f32) * D_FF ** -0.5,
        "norm_mix": 1.0 + 0.05 * nrm(ks[8], (L, D), f32),
        "w_in": nrm(ks[9], (L, D, n_in), f32) * D ** -0.5,
        "gla_gate_w2": nrm(ks[10], (L, GLA_RANK, GLA_HEADS * GLA_DK), f32) * GLA_RANK ** -0.5,
        "gla_gate_b": nrm(ks[11], (L, GLA_HEADS * GLA_DK), f32) * 0.01,
        "attn_sinks": nrm(ks[12], (L, N_Q_HEADS), f32) * 0.5,
        "gla_norm": 1.0 + 0.05 * nrm(ks[13], (L, GLA_DV), f32),
        "w_out": nrm(ks[14], (L, D_MIX, D), f32) * D_MIX ** -0.5,
        "norm_ffn2": 1.0 + 0.05 * nrm(ks[15], (L, D), f32),
        "ffn2_w1": nrm(ks[16], (L, D, D_FF), f32) * D ** -0.5,
        "ffn2_w3": nrm(ks[17], (L, D, D_FF), f32) * D ** -0.5,
        "ffn2_w2": nrm(ks[18], (L, D_FF, D), f32) * D_FF ** -0.5,
        "final_ada_w": nrm(ks[19], (D, 2 * D), f32) * D ** -0.5,
        "final_ada_b": nrm(ks[20], (2 * D,), f32) * 0.01,
        "final_norm": 1.0 + 0.05 * nrm(ks[21], (D,), f32),
    }


def reference(x, c, ada_w, ada_b, norm_ffn1, ffn1_w1, ffn1_w3, ffn1_w2, norm_mix, w_in,
              gla_gate_w2, gla_gate_b, attn_sinks, gla_norm, w_out, norm_ffn2, ffn2_w1,
              ffn2_w3, ffn2_w2, final_ada_w, final_ada_b, final_norm):
    B = x.shape[0]
    c_act = jax.nn.silu(c)
    h = x
    for l in range(DEPTH):
        mod = (c_act @ ada_w[l] + ada_b[l]).reshape(B, N_MOD, D_MODEL)[:, :, None, :]
        sh1, sc1, g1, sh2, sc2, g2, sh3, sc3, g3 = [mod[:, i] for i in range(N_MOD)]
        u = _rmsnorm_mod(h, norm_ffn1[l], sh1, sc1)
        h = h + 0.5 * g1 * _swiglu(u, ffn1_w1[l], ffn1_w3[l], ffn1_w2[l])
        u = _rmsnorm_mod(h, norm_mix[l], sh2, sc2)
        h = h + g2 * _mixer(u, w_in[l], gla_gate_w2[l], gla_gate_b[l], attn_sinks[l], gla_norm[l], w_out[l])
        u = _rmsnorm_mod(h, norm_ffn2[l], sh3, sc3)
        h = h + 0.5 * g3 * _swiglu(u, ffn2_w1[l], ffn2_w3[l], ffn2_w2[l])
    fmod = (c_act @ final_ada_w + final_ada_b).reshape(B, 2, D_MODEL)[:, :, None, :]
    return _rmsnorm_mod(h, final_norm, fmod[:, 0], fmod[:, 1])
```

```cpp
#include <hip/hip_runtime.h>
#include <cstdio>
#include <cstdint>
constexpr int BATCH = 2, SEQ = 16384, D = 2048, DEPTH = 4, M = BATCH * SEQ, FF = 5632, NUP = 2 * FF, NINR = 4368, NIN = 4608;
constexpr int NQH = 16, NKV = 2, HD = 64, GQA = 8, WIN = 128, BLK = 128, NBLK = SEQ / BLK;
constexpr int GH = 4, GDK = 128, GDV = 256, GRANK = 16, GCH = 64, NCHUNK = SEQ / GCH;
constexpr int NMOD = 9;
constexpr float EPS = 1e-6f;
constexpr int PC_QA = 0, PC_KA = 1024, PC_VA = 1152, PC_QG = 1280, PC_KG = 1792, PC_VG = 2304, PC_RG = 3328, PC_GL = 4352;
#ifndef GEMM_WGM
#define GEMM_WGM 8
#endif
namespace pg8 {
#define PG8_LAS __attribute__((address_space(3)))
typedef unsigned short bf16_t;
typedef short bf16x8 __attribute__((ext_vector_type(8)));
typedef float f32x4 __attribute__((ext_vector_type(4)));
typedef unsigned u32x4 __attribute__((ext_vector_type(4)));
typedef int i32x4 __attribute__((ext_vector_type(4)));
constexpr int BM = 256, BK = 64, HALF = 128, HTB = HALF * BK * 2  , STAGE_BYTES = 8 * HTB, NXCD = 8, WGM = GEMM_WGM;

__host__ __device__ __forceinline__ int lds_byte(int r, int c) { const int st = (r >> 4) * 2 + (c >> 5), rr = r & 15, cc = c & 31, ob = rr * 64 + cc * 2; return st * 1024 + (ob ^ (((ob >> 9) & 1) << 5)); }
__host__ __device__ __forceinline__ void stage_rc(int b, int& R, int& C) { const int st = b / 1024, sb = b % 1024, swz = sb ^ (((sb >> 9) & 1) << 5); R = (st >> 1) * 16 + swz / 64; C = (st & 1) * 32 + (swz % 64) / 2; }
__host__ __device__ __forceinline__ int perm32(int rho) { const int n = rho >> 4, i = rho & 15; return 8 * (i >> 2) + 4 * n + (i & 3); }

struct Unit { int pm, pn; };
struct Gemm { const bf16_t* A; const bf16_t* Bt; int M, N, K; };

struct StaticOrder {
    int nM, nN, nwg, G, c;
    __host__ __device__ void init(int M, int N, int G_, int c_) { nM = M / BM; nN = N / BM; nwg = nM * nN; G = G_; c = c_; }
    __host__ __device__ bool next(int i, Unit& u) const {
        const long L = (long)i * G + c; if (L >= nwg) return false;
        int wgid = (int)L; { const int q = nwg / NXCD, r = nwg % NXCD, xcd = wgid % NXCD, off = wgid / NXCD; wgid = (xcd < r ? xcd * (q + 1) : r * (q + 1) + (xcd - r) * q) + off; }
        const int nig = WGM * nN, gid = wgid / nig, fm = gid * WGM, gsz = (nM - fm) < WGM ? (nM - fm) : WGM;
        u.pm = fm + ((wgid % nig) % gsz); u.pn = (wgid % nig) / gsz; return true;
    }
    __device__ __forceinline__ void a_ready(const Unit&) const {}
    __device__ __forceinline__ void done(const Unit&) const {}
};
struct StaticOrderRev : StaticOrder {
    __host__ __device__ bool next(int i, Unit& u) const { if (!StaticOrder::next(i, u)) return false; u.pm = nM - 1 - u.pm; return true; }
};

__device__ __forceinline__ unsigned cvt_pk_bf16(float lo, float hi) { unsigned r; asm volatile("v_cvt_pk_bf16_f32 %0, %1, %2" : "=v"(r) : "v"(lo), "v"(hi)); return r; }
typedef float f32x2 __attribute__((ext_vector_type(2)));
typedef __bf16 bf16x2n __attribute__((ext_vector_type(2)));
__device__ __forceinline__ unsigned cvtpk(float lo, float hi) { f32x2 v = {lo, hi}; bf16x2n b = __builtin_convertvector(v, bf16x2n); return __builtin_bit_cast(unsigned, b); }
__device__ __forceinline__ float silu_f(float x) { return x * __builtin_amdgcn_rcpf(1.0f + __builtin_amdgcn_exp2f(-1.44269504089f * x)); }

struct EpiBf16 {
    static constexpr bool PERM = true, AFTER_DRAIN = false;
    bf16_t* O; int ldc;
    __device__ __forceinline__ void operator()(const f32x4 (&acc)[2][2][4][2], const Unit& u, int wr, int wc, int fr, int fq) const {
        const int row0 = u.pm * BM + wr * 64 + fr, col0 = u.pn * BM + wc * 32 + 8 * fq;
#pragma unroll
        for (int ai = 0; ai < 2; ++ai)
#pragma unroll
            for (int m = 0; m < 4; ++m) { bf16_t* rowp = O + (size_t)(row0 + ai * HALF + m * 16) * ldc + col0;
#pragma unroll
                for (int bj = 0; bj < 2; ++bj) { const f32x4 v0 = acc[ai][bj][m][0], v1 = acc[ai][bj][m][1];
                    u32x4 w; w.x = cvtpk(v0[0], v0[1]); w.y = cvtpk(v0[2], v0[3]); w.z = cvtpk(v1[0], v1[1]); w.w = cvtpk(v1[2], v1[3]);
                    *(u32x4*)(rowp + bj * HALF) = w; } }
    }
};
struct EpiSwiGLU {
    static constexpr bool PERM = true, AFTER_DRAIN = false;
    bf16_t* O; int ldc;
    __device__ __forceinline__ void operator()(const f32x4 (&acc)[2][2][4][2], const Unit& u, int wr, int wc, int fr, int fq) const {
        const int row0 = u.pm * BM + wr * 64 + fr, col0 = u.pn * HALF + wc * 32 + 8 * fq;
#pragma unroll
        for (int ai = 0; ai < 2; ++ai)
#pragma unroll
            for (int m = 0; m < 4; ++m) { bf16_t* rowp = O + (size_t)(row0 + ai * HALF + m * 16) * ldc + col0;
                const f32x4 g0 = acc[ai][0][m][0], g1 = acc[ai][0][m][1], u0 = acc[ai][1][m][0], u1 = acc[ai][1][m][1];
                float r[8];
#pragma unroll
                for (int i = 0; i < 4; ++i) { r[i] = silu_f(g0[i]) * u0[i]; r[4 + i] = silu_f(g1[i]) * u1[i]; }
                u32x4 w; w.x = cvtpk(r[0], r[1]); w.y = cvtpk(r[2], r[3]); w.z = cvtpk(r[4], r[5]); w.w = cvtpk(r[6], r[7]);
                *(u32x4*)rowp = w; }
    }
};
struct EpiResid {
    static constexpr bool PERM = false, AFTER_DRAIN = false;
    const float* base; float* out; int ldc; const float* gate; int gstride; float coef;
    __device__ __forceinline__ void operator()(const f32x4 (&acc)[2][2][4][2], const Unit& u, int wr, int wc, int fr, int fq) const {
        const int row0 = u.pm * BM + wr * 64 + fr, col0 = u.pn * BM + wc * 32 + 4 * fq;
        const float* gp = gate + (size_t)((u.pm * BM >= SEQ) ? 1 : 0) * gstride + col0;
        f32x4 gv[2][2];
#pragma unroll
        for (int bj = 0; bj < 2; ++bj)
#pragma unroll
            for (int n = 0; n < 2; ++n) gv[bj][n] = *(const f32x4*)(gp + bj * HALF + n * 16) * coef;
#pragma unroll
        for (int ai = 0; ai < 2; ++ai)
#pragma unroll
            for (int m = 0; m < 4; ++m) { const size_t off = (size_t)(row0 + ai * HALF + m * 16) * ldc + col0;
#pragma unroll
                for (int bj = 0; bj < 2; ++bj)
#pragma unroll
                    for (int n = 0; n < 2; ++n) { const f32x4 bs = *(const f32x4*)(base + off + bj * HALF + n * 16);
                        *(f32x4*)(out + off + bj * HALF + n * 16) = bs + gv[bj][n] * acc[ai][bj][m][n]; }
                asm volatile("" ::: "memory"); }
    }
};
struct EpiSwiGLU8 {
    typedef i32x4 acc_t;
    static constexpr bool PERM = true, AFTER_DRAIN = false;
    bf16_t* O; int ldc; const float* srow; const float* scol;
    __device__ __forceinline__ void operator()(const i32x4 (&acc)[2][2][4][2], const Unit& u, int wr, int wc, int fr, int fq) const {
        const int row0 = u.pm * BM + wr * 64 + fr, col0 = u.pn * HALF + wc * 32 + 8 * fq;
        float rs[2][4];
#pragma unroll
        for (int ai = 0; ai < 2; ++ai)
#pragma unroll
            for (int m = 0; m < 4; ++m) rs[ai][m] = srow[row0 + ai * HALF + m * 16];
        const float* sp = scol + u.pn * BM + wc * 32 + 8 * fq;
        const f32x4 sg0 = *(const f32x4*)(sp), sg1 = *(const f32x4*)(sp + 4), su0 = *(const f32x4*)(sp + HALF), su1 = *(const f32x4*)(sp + HALF + 4);
#pragma unroll
        for (int ai = 0; ai < 2; ++ai)
#pragma unroll
            for (int m = 0; m < 4; ++m) { bf16_t* rowp = O + (size_t)(row0 + ai * HALF + m * 16) * ldc + col0; const float r_ = rs[ai][m];
                const f32x4 g0 = __builtin_convertvector(acc[ai][0][m][0], f32x4) * (sg0 * r_), g1 = __builtin_convertvector(acc[ai][0][m][1], f32x4) * (sg1 * r_);
                const f32x4 u0 = __builtin_convertvector(acc[ai][1][m][0], f32x4) * (su0 * r_), u1 = __builtin_convertvector(acc[ai][1][m][1], f32x4) * (su1 * r_);
                float r[8];
#pragma unroll
                for (int i = 0; i < 4; ++i) { r[i] = silu_f(g0[i]) * u0[i]; r[4 + i] = silu_f(g1[i]) * u1[i]; }
                u32x4 w; w.x = cvtpk(r[0], r[1]); w.y = cvtpk(r[2], r[3]); w.z = cvtpk(r[4], r[5]); w.w = cvtpk(r[6], r[7]);
                *(u32x4*)rowp = w; }
    }
};
typedef _Float16 h16x8 __attribute__((ext_vector_type(8)));
typedef float f32x8 __attribute__((ext_vector_type(8)));
template <bool BASE_F32, bool HALF_COEF> struct EpiResidH {
    static constexpr bool PERM = true, AFTER_DRAIN = false;
    const void* base; _Float16* out; const float* gate; int ldc, gstride;
    __device__ __forceinline__ void operator()(const f32x4 (&acc)[2][2][4][2], const Unit& u, int wr, int wc, int fr, int fq) const {
        constexpr float coef = HALF_COEF ? 0.5f : 1.0f;
        const int row0 = u.pm * BM + wr * 64 + fr, col0 = u.pn * BM + wc * 32 + 8 * fq;
        const float* gp = gate + (size_t)((u.pm * BM >= SEQ) ? 1 : 0) * gstride + col0;
        f32x4 gv[2][2];
#pragma unroll
        for (int bj = 0; bj < 2; ++bj)
#pragma unroll
            for (int n = 0; n < 2; ++n) gv[bj][n] = *(const f32x4*)(gp + bj * HALF + 4 * n) * coef;
#pragma unroll
        for (int ai = 0; ai < 2; ++ai) {
            f32x4 bb[4][2][2];
#pragma unroll
            for (int m = 0; m < 4; ++m) { const size_t off = (size_t)(row0 + ai * HALF + m * 16) * ldc + col0;
#pragma unroll
                for (int bj = 0; bj < 2; ++bj) {
                    if (BASE_F32) { const float* bp = (const float*)base + off + bj * HALF; bb[m][bj][0] = *(const f32x4*)bp; bb[m][bj][1] = *(const f32x4*)(bp + 4); }
                    else { const h16x8 hb = *(const h16x8*)((const _Float16*)base + off + bj * HALF); const f32x8 fb = __builtin_convertvector(hb, f32x8);
                        bb[m][bj][0] = (f32x4){fb[0], fb[1], fb[2], fb[3]}; bb[m][bj][1] = (f32x4){fb[4], fb[5], fb[6], fb[7]}; } } }
#pragma unroll
            for (int m = 0; m < 4; ++m) { const size_t off = (size_t)(row0 + ai * HALF + m * 16) * ldc + col0;
#pragma unroll
                for (int bj = 0; bj < 2; ++bj) {
                    const f32x4 o0 = bb[m][bj][0] + gv[bj][0] * acc[ai][bj][m][0], o1 = bb[m][bj][1] + gv[bj][1] * acc[ai][bj][m][1];
                    const f32x8 o = {o0[0], o0[1], o0[2], o0[3], o1[0], o1[1], o1[2], o1[3]};
                    *(h16x8*)(out + off + bj * HALF) = __builtin_convertvector(o, h16x8); } }
            asm volatile("" ::: "memory"); }
    }
};
template <class E, class = void> struct AccOf { typedef f32x4 type; };
template <class E> struct AccOf<E, decltype((void)sizeof(typename E::acc_t))> { typedef typename E::acc_t type; };
__device__ __forceinline__ f32x4 mma16(bf16x8 b, bf16x8 a, f32x4 c) { return __builtin_amdgcn_mfma_f32_16x16x32_bf16(b, a, c, 0, 0, 0); }
__device__ __forceinline__ i32x4 mma16(bf16x8 b, bf16x8 a, i32x4 c) { return __builtin_amdgcn_mfma_i32_16x16x64_i8(__builtin_bit_cast(i32x4, b), __builtin_bit_cast(i32x4, a), c, 0, 0, 0); }
template <class Epi, class Sched, bool ALIGN_EPI = false, bool SP2 = false>
__device__ __forceinline__ void gemm_phase(PG8_LAS unsigned char* lds, const Gemm g, const Sched& S, const Epi& E) {
    int tid_ = threadIdx.x; asm volatile("" : "+v"(tid_));
    const int tid = tid_, wid = __builtin_amdgcn_readfirstlane(tid >> 6), lane = tid & 63, wr = wid >> 2, wc = wid & 3, fr = lane & 15, fq = lane >> 4;
    const int K = g.K, nt = K / BK;
    unsigned voffA[2], voffB[2];
#pragma unroll
    for (int i = 0; i < 2; ++i) { int R, C; stage_rc(tid * 16 + i * 8192, R, C); const int Rb = Epi::PERM ? ((R & ~31) + perm32(R & 31)) : R;
        voffA[i] = (unsigned)(R * K + C) * 2u; voffB[i] = (unsigned)(Rb * K + C) * 2u; }
    const size_t kstep = (size_t)(BK * 2);
    const size_t hstep = (size_t)HALF * K * 2;
    const size_t tstep = 2 * hstep;
    const unsigned ldsw = (unsigned)wid * 1024u;
    const int aoff = lds_byte(wr * 64 + fr, fq * 8), boff = lds_byte(wc * 32 + fr, fq * 8);
#define PG8_SA(b, h) (((b) * 2 + (h)) * HTB)
#define PG8_SB(b, h) ((4 + (b) * 2 + (h)) * HTB)
#define PG8_STAGE(bufoff, gbase, voff) do { _Pragma("unroll") for (int _i = 0; _i < 2; ++_i) \
        __builtin_amdgcn_global_load_lds((const unsigned*)((const char*)(gbase) + (voff)[_i]), (PG8_LAS unsigned*)(lds + (bufoff) + ldsw + _i * 8192), 16, 0, 0); } while (0)
#define PG8_LDA(dst, b, h) do { _Pragma("unroll") for (int m = 0; m < 4; ++m) _Pragma("unroll") for (int k = 0; k < 2; ++k) dst[m][k] = *(const PG8_LAS bf16x8*)(lds + PG8_SA(b, h) + aoff + m * 2048 + k * 1024); } while (0)
#define PG8_LDB(dst, b, h) do { _Pragma("unroll") for (int n = 0; n < 2; ++n) _Pragma("unroll") for (int k = 0; k < 2; ++k) dst[n][k] = *(const PG8_LAS bf16x8*)(lds + PG8_SB(b, h) + boff + n * 2048 + k * 1024); } while (0)
#define PG8_MMA(ai, bj, At, Bt) do { __builtin_amdgcn_s_setprio(1); _Pragma("unroll") for (int m = 0; m < 4; ++m) _Pragma("unroll") for (int n = 0; n < 2; ++n) _Pragma("unroll") for (int k = 0; k < 2; ++k) \
        acc[ai][bj][m][n] = mma16(Bt[n][k], At[m][k], acc[ai][bj][m][n]); __builtin_amdgcn_s_setprio(0); } while (0)
#define PG8_WAIT_V(n) asm volatile("s_waitcnt vmcnt(" #n ")" ::: "memory")
#define PG8_WAIT_L(n) asm volatile("s_waitcnt lgkmcnt(" #n ")" ::: "memory")
#define PG8_BAR __builtin_amdgcn_s_barrier()
#define PG8_SCHED __builtin_amdgcn_sched_barrier(0)
    Unit cur, nxt; int ui = 0;
    if (!S.next(0, cur)) return;
    typedef typename AccOf<Epi>::type acc_t;
    acc_t acc[2][2][4][2];
#pragma unroll
    for (int a = 0; a < 2; ++a)
#pragma unroll
        for (int b = 0; b < 2; ++b)
#pragma unroll
            for (int m = 0; m < 4; ++m)
#pragma unroll
                for (int n = 0; n < 2; ++n) acc[a][b][m][n] = acc_t{};
    bf16x8 At[4][2], B0[2][2], B1[2][2];
    const char* cA = (const char*)g.A + (size_t)cur.pm * tstep; const char* cB = (const char*)g.Bt + (size_t)cur.pn * tstep;
    S.a_ready(cur);
    if constexpr (SP2) {
        PG8_STAGE(PG8_SB(0, 0), cB, voffB); PG8_STAGE(PG8_SB(0, 1), cB + hstep, voffB); PG8_STAGE(PG8_SA(0, 0), cA, voffA); PG8_STAGE(PG8_SA(0, 1), cA + hstep, voffA);
        if (wr == 1) PG8_BAR;
        PG8_WAIT_V(2); PG8_BAR;
        PG8_STAGE(PG8_SB(1, 0), cB + kstep, voffB); PG8_STAGE(PG8_SA(1, 0), cA + kstep, voffA); PG8_STAGE(PG8_SB(1, 1), cB + hstep + kstep, voffB);
        PG8_WAIT_V(6); PG8_BAR;
    } else {
        PG8_STAGE(PG8_SB(0, 0), cB, voffB); PG8_STAGE(PG8_SA(0, 0), cA, voffA); PG8_STAGE(PG8_SB(0, 1), cB + hstep, voffB); PG8_STAGE(PG8_SA(0, 1), cA + hstep, voffA);
        if (wr == 1) PG8_BAR;
        PG8_WAIT_V(4); PG8_BAR;
        PG8_STAGE(PG8_SB(1, 0), cB + kstep, voffB); PG8_STAGE(PG8_SA(1, 0), cA + kstep, voffA); PG8_STAGE(PG8_SB(1, 1), cB + hstep + kstep, voffB);
        PG8_WAIT_V(6); PG8_BAR;
    }
    for (;;) {
        const bool has_next = S.next(ui + 1, nxt);
        const char* nA = has_next ? (const char*)g.A + (size_t)nxt.pm * tstep : cA; const char* nB = has_next ? (const char*)g.Bt + (size_t)nxt.pn * tstep : cB;
        for (int t = 0; t < nt; t += 2) {
            const bool last = (t == nt - 2);
            const char* a1 = cA + (size_t)(t + 1) * kstep;
            const char* a2 = last ? nA : cA + (size_t)(t + 2) * kstep; const char* b2 = last ? nB : cB + (size_t)(t + 2) * kstep;
            const char* a3 = a2 + kstep; const char* b3 = b2 + kstep;
            if (last && has_next) S.a_ready(nxt);
            if constexpr (SP2) {
            PG8_LDB(B0, 0, 0); PG8_LDB(B1, 0, 1); PG8_SCHED; PG8_LDA(At, 0, 0); PG8_STAGE(PG8_SA(1, 1), a1 + hstep, voffA);
            PG8_WAIT_V(8); PG8_WAIT_L(0); PG8_BAR; PG8_MMA(0, 0, At, B0); PG8_MMA(0, 1, At, B1); PG8_BAR; PG8_SCHED;
            PG8_LDA(At, 0, 1); PG8_STAGE(PG8_SB(0, 0), b2, voffB); PG8_STAGE(PG8_SB(0, 1), b2 + hstep, voffB); PG8_STAGE(PG8_SA(0, 0), a2, voffA);
            PG8_WAIT_V(8); PG8_WAIT_L(0); PG8_BAR; PG8_MMA(1, 0, At, B0); PG8_MMA(1, 1, At, B1); PG8_BAR; PG8_SCHED;
            PG8_LDB(B0, 1, 0); PG8_LDB(B1, 1, 1); PG8_SCHED; PG8_LDA(At, 1, 0); PG8_STAGE(PG8_SA(0, 1), a2 + hstep, voffA);
            PG8_WAIT_V(8); PG8_WAIT_L(0); PG8_BAR; PG8_MMA(0, 0, At, B0); PG8_MMA(0, 1, At, B1); PG8_BAR; PG8_SCHED;
            PG8_LDA(At, 1, 1); PG8_STAGE(PG8_SB(1, 0), b3, voffB); PG8_STAGE(PG8_SB(1, 1), b3 + hstep, voffB); PG8_STAGE(PG8_SA(1, 0), a3, voffA);
            PG8_WAIT_V(8); PG8_WAIT_L(0); PG8_BAR; PG8_MMA(1, 0, At, B0); PG8_MMA(1, 1, At, B1); PG8_BAR; PG8_SCHED;
            } else {
            PG8_LDB(B0, 0, 0); PG8_SCHED; PG8_LDA(At, 0, 0); PG8_STAGE(PG8_SA(1, 1), a1 + hstep, voffA);
            PG8_WAIT_L(8); PG8_BAR; PG8_WAIT_L(0); PG8_MMA(0, 0, At, B0); PG8_BAR; PG8_SCHED;
            PG8_LDB(B1, 0, 1); PG8_STAGE(PG8_SB(0, 0), b2, voffB);
            PG8_BAR; PG8_WAIT_L(0); PG8_MMA(0, 1, At, B1); PG8_BAR;
            PG8_LDA(At, 0, 1); PG8_STAGE(PG8_SA(0, 0), a2, voffA);
            PG8_BAR; PG8_WAIT_L(0); PG8_MMA(1, 0, At, B0); PG8_BAR; PG8_SCHED;
            PG8_STAGE(PG8_SB(0, 1), b2 + hstep, voffB);
            PG8_WAIT_V(6); PG8_BAR; PG8_MMA(1, 1, At, B1); PG8_BAR;
            PG8_LDB(B0, 1, 0); PG8_SCHED; PG8_LDA(At, 1, 0); PG8_STAGE(PG8_SA(0, 1), a2 + hstep, voffA);
            PG8_WAIT_L(8); PG8_BAR; PG8_WAIT_L(0); PG8_MMA(0, 0, At, B0); PG8_BAR; PG8_SCHED;
            PG8_LDB(B1, 1, 1); PG8_STAGE(PG8_SB(1, 0), b3, voffB);
            PG8_BAR; PG8_WAIT_L(0); PG8_MMA(0, 1, At, B1); PG8_BAR;
            PG8_LDA(At, 1, 1); PG8_STAGE(PG8_SA(1, 0), a3, voffA);
            PG8_BAR; PG8_WAIT_L(0); PG8_MMA(1, 0, At, B0); PG8_BAR; PG8_SCHED;
            PG8_STAGE(PG8_SB(1, 1), b3 + hstep, voffB);
            PG8_WAIT_V(6); PG8_BAR; PG8_MMA(1, 1, At, B1); PG8_BAR;
            }
        }
        if constexpr (ALIGN_EPI) { if (wr == 0) PG8_BAR; }
        if constexpr (!Epi::AFTER_DRAIN) { E(acc, cur, wr, wc, fr, fq); S.done(cur); }
        if (!has_next) break;
#pragma unroll
        for (int a = 0; a < 2; ++a)
#pragma unroll
            for (int b = 0; b < 2; ++b)
#pragma unroll
                for (int m = 0; m < 4; ++m)
#pragma unroll
                    for (int n = 0; n < 2; ++n) acc[a][b][m][n] = acc_t{};
        cur = nxt; cA = nA; cB = nB; ++ui;
        if constexpr (ALIGN_EPI) { if (wr == 1) PG8_BAR; }
    }
    PG8_WAIT_V(0);
    if constexpr (!ALIGN_EPI) { if (wr == 0) PG8_BAR; }
    PG8_BAR;
    if constexpr (Epi::AFTER_DRAIN) { E.fused(acc, cur, wr, wc, fr, fq, lds, wid, lane); S.done(cur); }
#undef PG8_SA
#undef PG8_SB
#undef PG8_STAGE
#undef PG8_LDA
#undef PG8_LDB
#undef PG8_MMA
#undef PG8_WAIT_V
#undef PG8_WAIT_L
#undef PG8_BAR
#undef PG8_SCHED
}
}

#ifndef GEMM_SP2
#define GEMM_SP2 true
#endif
#ifndef GEMM_ALIGN
#define GEMM_ALIGN true
#endif
#ifndef DN_ORDER
#define DN_ORDER pg8::StaticOrderRev
#endif
constexpr int NWAVES = 8;
#ifndef MK_N_LAUNCHES
#define MK_N_LAUNCHES 1
#endif
constexpr int NPH = 2 + 12 * DEPTH;

constexpr size_t MiB = 1u << 20;
constexpr size_t WS_CTL = 0, CTL_ZERO_BYTES = 1 * MiB;
constexpr size_t WS_MOD = 1 * MiB;
constexpr size_t WS_FMOD = WS_MOD + (size_t)DEPTH * BATCH * NMOD * D * 4;
constexpr size_t WS_W = 2 * MiB, W_LAYER = 158 * MiB, W_FFN = 66 * MiB, W_DN = 44 * MiB, W_IN = 132 * MiB, W_OUT = 150 * MiB;
constexpr size_t WS_U = 640 * MiB;
constexpr size_t WS_HID = 768 * MiB;
constexpr size_t WS_OMIX = 1120 * MiB;
constexpr size_t WS_KVT = 1248 * MiB;
constexpr size_t WS_ST = 1504 * MiB;
constexpr size_t WS_DEC = 1632 * MiB;
constexpr size_t WS_H = 1634 * MiB;
constexpr size_t WS_TOK0 = 1762 * MiB;
constexpr size_t WS_SROW = 1763 * MiB;
constexpr size_t WS_SCOL = 1764 * MiB;
constexpr size_t WS_SD = 1766 * MiB;
constexpr size_t SD_H = 0, SD_U = 16384, SD_OM = 32768, SD_A00 = 49152, SD_SLA = 1 * MiB, SD_SLB = 9 * MiB;
constexpr int SD_NP = NUP;
constexpr size_t WS_END = 1784 * MiB;
static_assert(WS_FMOD + (size_t)BATCH * 2 * D * 4 <= WS_W, "mod fits");
static_assert((size_t)NUP * D * 2 == 44 * MiB && (size_t)D * FF * 2 == 22 * MiB && (size_t)NIN * D * 2 == 18 * MiB && (size_t)D * D * 2 == 8 * MiB, "weight sizes");
static_assert(WS_W + DEPTH * W_LAYER <= WS_U && (size_t)M * D * 2 == 128 * MiB && (size_t)M * FF * 2 == 352 * MiB && (size_t)M * NIN * 2 <= 352 * MiB, "ws map");
constexpr int CW_TMO = 0, CW_CODE = 1;
constexpr int CW_BAR = 4096;

constexpr int RING_OFF = 0, RING_BYTES = 131072;
constexpr int LDSCTL_OFF = RING_BYTES, MISC_OFF = LDSCTL_OFF + 320;
constexpr int LDS_BYTES = 147456;
static_assert(MISC_OFF + 128 <= LDS_BYTES, "LDS map");

#define GAS __attribute__((address_space(1)))
#define LAS __attribute__((address_space(3)))
typedef unsigned short bf16;
typedef unsigned v4u __attribute__((ext_vector_type(4)));
typedef unsigned v2u __attribute__((ext_vector_type(2)));
typedef float f32x2 __attribute__((ext_vector_type(2)));
typedef float f32x4 __attribute__((ext_vector_type(4)));
typedef float f32x16 __attribute__((ext_vector_type(16)));
typedef short bf16x8 __attribute__((ext_vector_type(8)));
typedef short s16x4 __attribute__((ext_vector_type(4)));
typedef GAS unsigned gu32;
#define RLX_AGENT __ATOMIC_RELAXED, __HIP_MEMORY_SCOPE_AGENT
#define LDS_WAIT() asm volatile("s_waitcnt lgkmcnt(0)" ::: "memory")
#define VM_WAIT() asm volatile("s_waitcnt vmcnt(0)" ::: "memory")
#define MFMA32(a, b, c) __builtin_amdgcn_mfma_f32_32x32x16_bf16((a), (b), (c), 0, 0, 0)
__device__ __forceinline__ unsigned f2bf(float f) { unsigned u = __builtin_bit_cast(unsigned, f); return (u + 0x7fffu + ((u >> 16) & 1u)) >> 16; }
__device__ __forceinline__ unsigned pk2(float lo, float hi) { return pg8::cvtpk(lo, hi); }
__device__ __forceinline__ float bf2f(unsigned b) { return __builtin_bit_cast(float, b << 16); }
__device__ __forceinline__ int crow(int r, int hi) { return (r & 3) + 8 * (r >> 2) + 4 * hi; }
__device__ __forceinline__ bf16x8 pack8(const f32x16& x, int s, float sc) {
    v4u p; p.x = pk2(x[8 * s + 0] * sc, x[8 * s + 1] * sc); p.y = pk2(x[8 * s + 2] * sc, x[8 * s + 3] * sc); p.z = pk2(x[8 * s + 4] * sc, x[8 * s + 5] * sc); p.w = pk2(x[8 * s + 6] * sc, x[8 * s + 7] * sc);
    return __builtin_bit_cast(bf16x8, p);
}
__device__ __forceinline__ float shx(float v, int o, int lane) { return __builtin_bit_cast(float, __builtin_amdgcn_ds_bpermute((lane ^ o) << 2, __builtin_bit_cast(int, v))); }
__device__ __forceinline__ float wave_max(float v, int lane) {
#pragma unroll
    for (int o = 1; o < 64; o <<= 1) v = fmaxf(v, shx(v, o, lane));
    return v;
}
__device__ __forceinline__ unsigned q8x4(f32x4 y, float inv) {
    const int a = (int)__builtin_rintf(y.x * inv), b = (int)__builtin_rintf(y.y * inv), c = (int)__builtin_rintf(y.z * inv), d = (int)__builtin_rintf(y.w * inv);
    return (unsigned)(a & 0xff) | ((unsigned)(b & 0xff) << 8) | ((unsigned)(c & 0xff) << 16) | ((unsigned)(d & 0xff) << 24);
}
__device__ __forceinline__ float wave_sum(float v, int lane) {
#pragma unroll
    for (int o = 1; o < 64; o <<= 1) v += shx(v, o, lane);
    return v;
}
#define XB_TMO      128
#define XB_XCNT(j)  (256  + 64 * (j))
#define XB_XSUB(j)  (1280 + 64 * (j))
#define XB_XGEN(j)  (2304 + 64 * (j))
#define XB_TOP      3328
#define XB_TOPGEN   3392
#define XCD_BAR_WORDS 3456
#define XB_SPIN_CAP (1u << 18)

__device__ __forceinline__ unsigned xb_ld(unsigned* p)              { return __hip_atomic_load(p, __ATOMIC_RELAXED, __HIP_MEMORY_SCOPE_AGENT); }
__device__ __forceinline__ unsigned xb_add(unsigned* p, unsigned v) { return __hip_atomic_fetch_add(p, v, __ATOMIC_RELAXED, __HIP_MEMORY_SCOPE_AGENT); }
__device__ __forceinline__ unsigned xb_xcc_id() { return (unsigned)__builtin_amdgcn_s_getreg((3 << 11) | 20) & 0xFu; }
#define XB_SPIN(cond, bar) do { unsigned _sp = 0; while (cond) { __builtin_amdgcn_s_sleep(1); \
    if ((++_sp & 255u) == 0u) { if (xb_ld(&(bar)[XB_TMO])) break; if (_sp > XB_SPIN_CAP) { atomicAdd(&(bar)[XB_TMO], 1u); break; } } } } while (0)

struct XcdBarrier {
    unsigned* bar; unsigned x;
    volatile LAS unsigned* st;
};

__device__ __forceinline__ XcdBarrier xcd_barrier_post(unsigned* bar, volatile LAS unsigned* st) {
    XcdBarrier b; b.bar = bar; b.x = xb_xcc_id(); b.st = st;
    if (threadIdx.x == 0) (void)xb_add(&bar[XB_XCNT(b.x)], 1u);
    return b;
}
__device__ __forceinline__ void xcd_barrier_complete(unsigned* bar, unsigned x, unsigned& nloc, unsigned& nx) {
    const unsigned G = gridDim.x * gridDim.y * gridDim.z;
    unsigned sum, cnt, mine, sp = 0u;
    for (;;) {
        sum = 0u; cnt = 0u; mine = 0u;
#pragma unroll
        for (unsigned j = 0; j < 16; ++j) { const unsigned c = xb_ld(&bar[XB_XCNT(j)]); sum += c; cnt += (c > 0u) ? 1u : 0u; mine = (j == x) ? c : mine; }
        if (sum == G) break;
        __builtin_amdgcn_s_sleep(1);
        if ((++sp & 255u) == 0u) { if (xb_ld(&bar[XB_TMO])) break; if (sp > XB_SPIN_CAP) { atomicAdd(&bar[XB_TMO], 1u); break; } }
    }
    nloc = mine > 0u ? mine : 1u; nx = cnt > 0u ? cnt : 1u;
}

template <class SIDE>
__device__ __forceinline__ void xcd_barrier_side(const XcdBarrier& b, SIDE side) {
    asm volatile("s_waitcnt vmcnt(0)" ::: "memory");
    __syncthreads();
    if (threadIdx.x >= 64) { side(); asm volatile("s_waitcnt vmcnt(0)" ::: "memory"); }
    else if (threadIdx.x == 0) {
        unsigned* bar = b.bar;
#ifdef PROBE_WAIT
        const unsigned long long t0_ = wall_clock64();
        const unsigned rnd_ = b.st[6]; b.st[6] = rnd_ + 1u;
        atomicMax(&bar[4204 + rnd_], (unsigned)t0_);
#endif
        __builtin_amdgcn_s_waitcnt(0);
        unsigned nloc = b.st[0], nx = b.st[1];
        if (nloc == 0u) { xcd_barrier_complete(bar, b.x, nloc, nx); b.st[0] = nloc; b.st[1] = nx; }
#ifdef EARLY_WB
        __builtin_amdgcn_fence(__ATOMIC_RELEASE, "agent");
        asm volatile("s_waitcnt vmcnt(0)" ::: "memory");
#endif
        const unsigned old = xb_add(&bar[XB_XSUB(b.x)], 1u);
        const unsigned gen = old / nloc;
        if (old + 1u == (gen + 1u) * nloc) {
#ifdef PROBE_WAIT
            const unsigned long long t1_ = wall_clock64();
#endif
            __builtin_amdgcn_fence(__ATOMIC_RELEASE, "agent");
            asm volatile("s_waitcnt vmcnt(0)" ::: "memory");
#ifdef PROBE_WAIT
            b.st[5] += (unsigned)(wall_clock64() - t1_);
#endif
            const unsigned og = xb_add(&bar[XB_TOP], 1u);
            const unsigned tg = og / nx;
            if (og + 1u == (tg + 1u) * nx) xb_add(&bar[XB_TOPGEN], 1u);
            else XB_SPIN(xb_ld(&bar[XB_TOPGEN]) == tg, bar);
            __builtin_amdgcn_fence(__ATOMIC_ACQUIRE, "agent");
#ifndef BAR_FLAT
            xb_add(&bar[XB_XGEN(b.x)], 1u);
#endif
            asm volatile("s_waitcnt vmcnt(0)" ::: "memory");
        } else {
#ifdef BAR_FLAT
            XB_SPIN(xb_ld(&bar[XB_TOPGEN]) == gen, bar);
#else
            XB_SPIN(xb_ld(&bar[XB_XGEN(b.x)]) == gen, bar);
#endif
            __builtin_amdgcn_fence(__ATOMIC_ACQUIRE, "agent");
            asm volatile("s_waitcnt vmcnt(0)" ::: "memory");
        }
#ifdef PROBE_WAIT
        { const unsigned long long t2_ = wall_clock64(); { const int q_ = rnd_ >= 2u ? (int)((rnd_ - 2u) % 12u) : 12; if ((PROBE_QMASK >> q_) & 1) b.st[4] += (unsigned)(t2_ - t0_); } if (blockIdx.x == 0) b.st[7] += (unsigned)t2_ - xb_ld(&bar[4204 + rnd_]); }
#endif
    }
    __syncthreads();
}
__device__ __forceinline__ void xcd_barrier(const XcdBarrier& b) { xcd_barrier_side(b, []() {}); }

struct Args { const float* in[22]; float* out; unsigned char* ws; int ph_lo, ph_hi, li, pad; };
struct Ctx {
    LAS unsigned char* lds;
    int tid, lane, wave, G, gw, NGW;
};
enum { I_X = 0, I_C, I_ADAW, I_ADAB, I_NFFN1, I_F1W1, I_F1W3, I_F1W2, I_NMIX, I_WIN, I_GW2, I_GB, I_SINK, I_GNORM, I_WOUT, I_NFFN2, I_F2W1, I_F2W3, I_F2W2, I_FADAW, I_FADAB, I_FNORM };

__device__ __forceinline__ void p0_mod(const Ctx& C, const Args& a) {
    LAS float* cact = (LAS float*)C.lds;
    LAS float* red = (LAS float*)(C.lds + 16384);
    for (int i = C.tid; i < BATCH * D; i += NWAVES * 64) { const float c = a.in[I_C][i]; cact[i] = c / (1.0f + expf(-c)); }
    __syncthreads();
    float* modp = (float*)(a.ws + WS_MOD); float* fmodp = (float*)(a.ws + WS_FMOD);
    constexpr int IT_L = NMOD * D / 256, NITEM = DEPTH * IT_L + 2 * D / 256;
    for (int it = blockIdx.x; it < NITEM; it += C.G) {
        const float* W; const float* bias; float* o0; int N, c0;
        if (it < DEPTH * IT_L) { const int l = it / IT_L; c0 = (it % IT_L) * 256; N = NMOD * D; W = a.in[I_ADAW] + (size_t)l * D * N; bias = a.in[I_ADAB] + (size_t)l * N; o0 = modp + (size_t)l * BATCH * N; }
        else { c0 = (it - DEPTH * IT_L) * 256; N = 2 * D; W = a.in[I_FADAW]; bias = a.in[I_FADAB]; o0 = fmodp; }
        f32x4 a0 = {0.f, 0.f, 0.f, 0.f}, a1 = {0.f, 0.f, 0.f, 0.f};
        const int kb = 256 * C.wave;
        const float* wp = W + (size_t)kb * N + c0 + 4 * C.lane;
#pragma unroll 8
        for (int k = 0; k < 256; ++k) { const f32x4 w = *(const f32x4*)(wp + (size_t)k * N); const float x0 = cact[kb + k], x1 = cact[D + kb + k]; a0 += w * x0; a1 += w * x1; }
#pragma unroll
        for (int j = 0; j < 4; ++j) { red[(C.wave * 2 + 0) * 256 + 4 * C.lane + j] = a0[j]; red[(C.wave * 2 + 1) * 256 + 4 * C.lane + j] = a1[j]; }
        __syncthreads();
        { const int b = C.tid >> 8, col = C.tid & 255; float s = 0.f;
#pragma unroll
          for (int w = 0; w < 8; ++w) s += red[(w * 2 + b) * 256 + col];
          o0[(size_t)b * N + c0 + col] = s + bias[c0 + col]; }
        __syncthreads();
    }
}
__device__ __forceinline__ void p0_transpose_item(const float* W, int K, int N, int nvalid, bf16* dst, LAS float* scr, int k0, int n0, int lane) {
    const int col = n0 + (lane & 31); const bool ok = col < nvalid;
    const float* src = W + (size_t)(k0 + (lane >> 5)) * N + (ok ? col : 0);
    float t[32];
#pragma unroll
    for (int i = 0; i < 32; ++i) t[i] = src[(size_t)(2 * i) * N];
#pragma unroll
    for (int i = 0; i < 32; ++i) scr[(2 * i + (lane >> 5)) * 33 + (lane & 31)] = ok ? t[i] : 0.f;
    LDS_WAIT(); asm volatile("" ::: "memory");
    const int c = lane & 7;
#pragma unroll
    for (int j = 0; j < 4; ++j) { const int n = (lane >> 3) + 8 * j; const LAS float* s = scr + (8 * c) * 33 + n;
        v4u o; o.x = pk2(s[0 * 33], s[1 * 33]); o.y = pk2(s[2 * 33], s[3 * 33]); o.z = pk2(s[4 * 33], s[5 * 33]); o.w = pk2(s[6 * 33], s[7 * 33]);
        *(GAS v4u*)(dst + (size_t)n * K + k0 + 8 * c) = o; }
    LDS_WAIT(); asm volatile("" ::: "memory");
}
__device__ __forceinline__ void p0_transpose_item_i8(const float* W, int N, int K8, signed char* dst8, const LAS float* cmax, float* sc, LAS float* scr, int k0, int n0, int lane) {
    const float* src = W + (size_t)(k0 + (lane >> 5)) * N + n0 + (lane & 31);
    float t[32];
#pragma unroll
    for (int i = 0; i < 32; ++i) t[i] = src[(size_t)(2 * i) * N];
#pragma unroll
    for (int i = 0; i < 32; ++i) scr[(2 * i + (lane >> 5)) * 33 + (lane & 31)] = t[i];
    LDS_WAIT(); asm volatile("" ::: "memory");
    const int c = lane & 7;
#pragma unroll
    for (int j = 0; j < 4; ++j) { const int n = (lane >> 3) + 8 * j; const LAS float* p = scr + (8 * c) * 33 + n;
        const float sv = cmax[n] * (1.0f / 127.0f), inv = sv > 0.f ? 1.0f / sv : 0.f;
        if (k0 == 0 && c == 0) sc[n] = sv;
        v2u o; o.x = q8x4((f32x4){p[0 * 33], p[1 * 33], p[2 * 33], p[3 * 33]}, inv); o.y = q8x4((f32x4){p[4 * 33], p[5 * 33], p[6 * 33], p[7 * 33]}, inv);
        *(GAS v2u*)(dst8 + (size_t)n * K8 + k0 + 8 * c) = o; }
    LDS_WAIT(); asm volatile("" ::: "memory");
}
constexpr int P0_I_UP = (D / 64) * (FF / 32), P0_I_DN = (FF / 64) * (D / 32), P0_I_IN = (D / 64) * (NIN / 32), P0_I_OUT = (D / 64) * (D / 32);
constexpr int P0_NCV0 = DEPTH * (2 * P0_I_DN + P0_I_IN + P0_I_OUT);
constexpr int P0_NUPT = DEPTH * 4 * (FF / 32);
__device__ __forceinline__ void p0_up_task(const Ctx& C, const Args& a, LAS float* scr, LAS float* cm, int it) {
    constexpr int NB = FF / 32;
    const int l = it / (4 * NB); int r = it % (4 * NB); const int f = r / (2 * NB); r %= 2 * NB; const int which = r / NB, nb = r % NB;
    const float* W = a.in[f ? (which ? I_F2W3 : I_F2W1) : (which ? I_F1W3 : I_F1W1)] + (size_t)l * D * FF;
    { const float* src = W + (size_t)(256 * C.wave + (C.lane >> 5)) * FF + 32 * nb + (C.lane & 31);
      float mx = 0.f;
#pragma unroll 16
      for (int i = 0; i < 128; ++i) mx = fmaxf(mx, fabsf(src[(size_t)(2 * i) * FF]));
      mx = fmaxf(mx, shx(mx, 32, C.lane));
      if (C.lane < 32) cm[C.wave * 32 + C.lane] = mx; }
    __syncthreads();
    if (C.tid < 32) { float m = cm[C.tid];
#pragma unroll
        for (int w = 1; w < NWAVES; ++w) m = fmaxf(m, cm[w * 32 + C.tid]);
        cm[NWAVES * 32 + C.tid] = m; }
    __syncthreads();
    unsigned char* wl = a.ws + WS_W + (size_t)l * W_LAYER;
    const int jr = (nb >> 2) * 256 + (nb & 3) * 32 + which * 128;
    const size_t so = (size_t)(l * 2 + f) * NUP + jr;
#pragma unroll 1
    for (int q = 0; q < 4; ++q)
        p0_transpose_item_i8(W, FF, D, (signed char*)(wl + f * W_FFN) + (size_t)jr * D, cm + NWAVES * 32, (float*)(a.ws + WS_SCOL) + so, scr, 64 * (4 * C.wave + q), 32 * nb, C.lane);
    __syncthreads();
}
__device__ __forceinline__ void p0_conv0_item(const Args& a, LAS float* scr, int it, int lane) {
    constexpr int PER_L = 2 * P0_I_DN + P0_I_IN + P0_I_OUT;
    const int l = it / PER_L; int r = it % PER_L;
    unsigned char* wl = a.ws + WS_W + (size_t)l * W_LAYER;
    if (r < 2 * P0_I_DN) { const int f = r / P0_I_DN; r %= P0_I_DN; const int kb = r / (D / 32), nb = r % (D / 32);
        const float* W = a.in[f ? I_F2W2 : I_F1W2] + (size_t)l * FF * D;
        p0_transpose_item(W, FF, D, D, (bf16*)(wl + f * W_FFN + W_DN) + (size_t)(32 * nb) * FF, scr, 64 * kb, 32 * nb, lane); }
    else { r -= 2 * P0_I_DN;
        if (r < P0_I_IN) { const int kb = r / (NIN / 32), nb = r % (NIN / 32);
            p0_transpose_item(a.in[I_WIN] + (size_t)l * D * NINR, D, NINR, NINR, (bf16*)(wl + W_IN) + (size_t)(32 * nb) * D, scr, 64 * kb, 32 * nb, lane); }
        else { r -= P0_I_IN; const int kb = r / (D / 32), nb = r % (D / 32);
            p0_transpose_item(a.in[I_WOUT] + (size_t)l * D * D, D, D, D, (bf16*)(wl + W_OUT) + (size_t)(32 * nb) * D, scr, 64 * kb, 32 * nb, lane); } }
}
constexpr int P0_MOD_ITEMS = DEPTH * (NMOD * D / 256) + 2 * D / 256;
#ifndef P0_CV_LO
#define P0_CV_LO 159
#define P0_CV_HI 308
#endif
__device__ __forceinline__ unsigned wg_draw(volatile LAS unsigned* q, int lane) {
    unsigned v = 0u; if (lane == 0) v = __hip_atomic_fetch_add((LAS unsigned*)q, 1u, __ATOMIC_RELAXED, __HIP_MEMORY_SCOPE_WORKGROUP);
    return (unsigned)__builtin_amdgcn_readfirstlane((int)v);
}
__device__ __forceinline__ void p0_phase_a(const Ctx& C, const Args& a, volatile LAS unsigned* q) {
    LAS float* scr = (LAS float*)(C.lds + 32768 + C.wave * 8704);
    LAS float* cm = (LAS float*)(C.lds + 32768 + NWAVES * 8704);
    const int w = blockIdx.x, G = C.G;
    int c0, cn;
    if (G == 256) { const int extra = P0_MOD_ITEMS - 256; c0 = w < extra ? P0_CV_LO * w : P0_CV_LO * extra + P0_CV_HI * (w - extra); cn = w < extra ? P0_CV_LO : P0_CV_HI; }
    else { c0 = (int)((long long)P0_NCV0 * w / G); cn = (int)((long long)P0_NCV0 * (w + 1) / G) - c0; }
    if (c0 > P0_NCV0) c0 = P0_NCV0;
    if (c0 + cn > P0_NCV0) cn = P0_NCV0 - c0;
    if (G == 256 && w == G - 1) cn = P0_NCV0 - c0;
    const int m0 = (int)((long long)P0_NUPT * w / G), m1 = (int)((long long)P0_NUPT * (w + 1) / G);
#pragma unroll 1
    for (int t = m0; t < m1; ++t) p0_up_task(C, a, scr, cm, t);
    for (;;) { const unsigned i = wg_draw(q, C.lane); if (i >= (unsigned)cn) break; p0_conv0_item(a, scr, c0 + (int)i, C.lane); }
}

template <bool FINAL>
__device__ __forceinline__ void norm_phase(const Ctx& C, const float* src, const float* w, const float* shv, const float* scv, int bstride, bf16* u, float* outf) {
    int cur_b = -1; f32x4 A[8], B[8];
#pragma unroll
    for (int j = 0; j < 8; ++j) { A[j] = (f32x4){0.f, 0.f, 0.f, 0.f}; B[j] = A[j]; }
    for (int m = C.gw; m < M; m += C.NGW) {
        const int b = m >= SEQ ? 1 : 0;
        if (b != cur_b) { cur_b = b;
#pragma unroll
            for (int j = 0; j < 8; ++j) { const int col = 4 * (C.lane + 64 * j); const f32x4 wv = *(const f32x4*)(w + col), sc = *(const f32x4*)(scv + (size_t)b * bstride + col); A[j] = wv * (sc + 1.0f); B[j] = *(const f32x4*)(shv + (size_t)b * bstride + col); } }
        const f32x4* xr = (const f32x4*)(src + (size_t)m * D) + C.lane;
        f32x4 v[8]; float s = 0.f;
#pragma unroll
        for (int j = 0; j < 8; ++j) v[j] = xr[64 * j];
#pragma unroll
        for (int j = 0; j < 8; ++j) s += (v[j].x * v[j].x + v[j].y * v[j].y) + (v[j].z * v[j].z + v[j].w * v[j].w);
        const float r = 1.0f / sqrtf(wave_sum(s, C.lane) * (1.0f / D) + EPS);
#pragma unroll
        for (int j = 0; j < 8; ++j) { const f32x4 y = v[j] * r * A[j] + B[j];
            if (FINAL) ((f32x4*)(outf + (size_t)m * D))[C.lane + 64 * j] = y;
            else { v2u o; o.x = pk2(y.x, y.y); o.y = pk2(y.z, y.w); ((v2u*)(u + (size_t)m * D))[C.lane + 64 * j] = o; } }
    }
}

typedef _Float16 h16x8n __attribute__((ext_vector_type(8)));
typedef float f32x8n __attribute__((ext_vector_type(8)));
template <bool FINAL>
__device__ __forceinline__ void norm_phase_h(const Ctx& C, const _Float16* src, const float* w, const float* shv, const float* scv, int bstride, bf16* u, float* outf) {
    int cur_b = -1; f32x4 A[8], B[8];
#pragma unroll
    for (int j = 0; j < 8; ++j) { A[j] = (f32x4){0.f, 0.f, 0.f, 0.f}; B[j] = A[j]; }
    for (int m = C.gw; m < M; m += C.NGW) {
        const int b = m >= SEQ ? 1 : 0;
        if (b != cur_b) { cur_b = b;
#pragma unroll
            for (int j = 0; j < 8; ++j) { const int col = 8 * (C.lane + 64 * (j >> 1)) + 4 * (j & 1); const f32x4 wv = *(const f32x4*)(w + col), sc = *(const f32x4*)(scv + (size_t)b * bstride + col); A[j] = wv * (sc + 1.0f); B[j] = *(const f32x4*)(shv + (size_t)b * bstride + col); } }
        const h16x8n* xr = (const h16x8n*)(src + (size_t)m * D) + C.lane;
        h16x8n q[4]; f32x4 v[8]; float s = 0.f;
#pragma unroll
        for (int j = 0; j < 4; ++j) q[j] = xr[64 * j];
#pragma unroll
        for (int j = 0; j < 4; ++j) { const f32x8n f = __builtin_convertvector(q[j], f32x8n); v[2 * j] = (f32x4){f[0], f[1], f[2], f[3]}; v[2 * j + 1] = (f32x4){f[4], f[5], f[6], f[7]}; }
#pragma unroll
        for (int j = 0; j < 8; ++j) s += (v[j].x * v[j].x + v[j].y * v[j].y) + (v[j].z * v[j].z + v[j].w * v[j].w);
        const float r = 1.0f / sqrtf(wave_sum(s, C.lane) * (1.0f / D) + EPS);
#pragma unroll
        for (int j = 0; j < 4; ++j) { const f32x4 y0 = v[2 * j] * r * A[2 * j] + B[2 * j], y1 = v[2 * j + 1] * r * A[2 * j + 1] + B[2 * j + 1];
            if (FINAL) { f32x4* o = (f32x4*)(outf + (size_t)m * D + 8 * (C.lane + 64 * j)); o[0] = y0; o[1] = y1; }
            else { v4u o; o.x = pk2(y0.x, y0.y); o.y = pk2(y0.z, y0.w); o.z = pk2(y1.x, y1.y); o.w = pk2(y1.z, y1.w); ((v4u*)(u + (size_t)m * D))[C.lane + 64 * j] = o; } }
    }
}

template <bool SRC_F32>
__device__ __forceinline__ void norm_q8(const Ctx& C, const void* src, const float* w, const float* shv, const float* scv, int bstride, signed char* u8, float* srow) {
    int cur_b = -1; f32x4 A[8], B[8];
#pragma unroll
    for (int j = 0; j < 8; ++j) { A[j] = (f32x4){0.f, 0.f, 0.f, 0.f}; B[j] = A[j]; }
    for (int m = C.gw; m < M; m += C.NGW) {
        const int b = m >= SEQ ? 1 : 0;
        if (b != cur_b) { cur_b = b;
#pragma unroll
            for (int j = 0; j < 8; ++j) { const int col = 8 * (C.lane + 64 * (j >> 1)) + 4 * (j & 1); const f32x4 wv = *(const f32x4*)(w + col), sc = *(const f32x4*)(scv + (size_t)b * bstride + col); A[j] = wv * (sc + 1.0f); B[j] = *(const f32x4*)(shv + (size_t)b * bstride + col); } }
        f32x4 v[8]; float s = 0.f;
        if (SRC_F32) { const f32x4* xr = (const f32x4*)((const float*)src + (size_t)m * D);
#pragma unroll
            for (int j = 0; j < 8; ++j) v[j] = xr[2 * (C.lane + 64 * (j >> 1)) + (j & 1)]; }
        else { const h16x8n* xr = (const h16x8n*)((const _Float16*)src + (size_t)m * D) + C.lane;
#pragma unroll
            for (int j = 0; j < 4; ++j) { const f32x8n f = __builtin_convertvector(xr[64 * j], f32x8n); v[2 * j] = (f32x4){f[0], f[1], f[2], f[3]}; v[2 * j + 1] = (f32x4){f[4], f[5], f[6], f[7]}; } }
#pragma unroll
        for (int j = 0; j < 8; ++j) s += (v[j].x * v[j].x + v[j].y * v[j].y) + (v[j].z * v[j].z + v[j].w * v[j].w);
        const float r = 1.0f / sqrtf(wave_sum(s, C.lane) * (1.0f / D) + EPS);
        float am = 0.f;
#pragma unroll
        for (int j = 0; j < 8; ++j) { v[j] = v[j] * r * A[j] + B[j]; am = fmaxf(am, fmaxf(fmaxf(fabsf(v[j].x), fabsf(v[j].y)), fmaxf(fabsf(v[j].z), fabsf(v[j].w)))); }
        am = wave_max(am, C.lane);
        const float inv = am > 0.f ? 127.0f / am : 0.f;
        if (C.lane == 0) srow[m] = am * (1.0f / 127.0f);
#pragma unroll
        for (int j = 0; j < 4; ++j) { v2u o; o.x = q8x4(v[2 * j], inv); o.y = q8x4(v[2 * j + 1], inv); ((v2u*)(u8 + (size_t)m * D))[C.lane + 64 * j] = o; }
    }
}

constexpr int AT_KROW = 144, AT_VROW = 520, AT_K_OFF = 0, AT_V_OFF = 256 * AT_KROW;
__device__ __forceinline__ void attn_unit(const Ctx& C, const bf16* __restrict__ P, bf16* __restrict__ O, const float* sinks, int unit) {
    const int kv = unit & 1, n = (unit >> 1) & (NBLK - 1), b = unit >> 8;
    const int tb = b * SEQ + n * BLK;
    LAS unsigned char* KL = C.lds + AT_K_OFF; LAS unsigned char* VL = C.lds + AT_V_OFF;
#pragma unroll
    for (int j = 0; j < 4; ++j) { const int idx = C.tid + 512 * j, key = idx >> 3, part = idx & 7;
        v4u kq = {0u, 0u, 0u, 0u}, vq = {0u, 0u, 0u, 0u};
        if (n > 0 || key >= BLK) { const bf16* row = P + (size_t)(tb + key - BLK) * NIN; kq = *(const v4u*)(row + PC_KA + kv * HD + 8 * part); vq = *(const v4u*)(row + PC_VA + kv * HD + 8 * part); }
        *(LAS v4u*)(KL + key * AT_KROW + part * 16) = kq;
        const unsigned vv[4] = {vq.x, vq.y, vq.z, vq.w};
#pragma unroll
        for (int q = 0; q < 4; ++q) { *(LAS unsigned short*)(VL + (8 * part + 2 * q) * AT_VROW + key * 2) = (unsigned short)(vv[q] & 0xffffu); *(LAS unsigned short*)(VL + (8 * part + 2 * q + 1) * AT_VROW + key * 2) = (unsigned short)(vv[q] >> 16); } }
    __syncthreads();
    const int r = C.lane & 31, h = C.lane >> 5, head = kv * GQA + C.wave;
    const float slope = exp2f(-0.5f * (float)(head + 1)), sink = sinks[head];
#pragma unroll 1
    for (int qb = 0; qb < 4; ++qb) {
        bf16x8 qf[4];
        { const bf16* qrow = P + (size_t)(tb + 32 * qb + r) * NIN + PC_QA + head * HD + 8 * h;
#pragma unroll
          for (int s = 0; s < 4; ++s) qf[s] = *(const bf16x8*)(qrow + 16 * s); }
        f32x16 sa[5];
#pragma unroll
        for (int k5 = 0; k5 < 5; ++k5) {
#pragma unroll
            for (int i = 0; i < 16; ++i) sa[k5][i] = 0.f;
#pragma unroll
            for (int s = 0; s < 4; ++s) { const bf16x8 kf = *(const LAS bf16x8*)(KL + (32 * (qb + k5) + r) * AT_KROW + (16 * s + 8 * h) * 2); sa[k5] = MFMA32(kf, qf[s], sa[k5]); } }
        const int qi = 32 * qb + r; float mx = -INFINITY;
#pragma unroll
        for (int k5 = 0; k5 < 5; ++k5)
#pragma unroll
            for (int i = 0; i < 16; ++i) { const int kj = 32 * (qb + k5) + crow(i, h), dist = qi + BLK - kj; const bool valid = (dist >= 0) && (dist < WIN) && (n > 0 || kj >= BLK);
                const float v = valid ? sa[k5][i] * 0.125f - slope * (float)dist : -INFINITY; sa[k5][i] = v; mx = fmaxf(mx, v); }
        mx = fmaxf(mx, shx(mx, 32, C.lane)); mx = fmaxf(mx, sink);
        float sum = 0.f;
#pragma unroll
        for (int k5 = 0; k5 < 5; ++k5)
#pragma unroll
            for (int i = 0; i < 16; ++i) { const float p = __expf(sa[k5][i] - mx); sa[k5][i] = p; sum += p; }
        sum += shx(sum, 32, C.lane); sum += __expf(sink - mx);
        const float inv = 1.0f / sum;
        f32x16 o[2];
#pragma unroll
        for (int i = 0; i < 16; ++i) { o[0][i] = 0.f; o[1][i] = 0.f; }
#pragma unroll
        for (int k5 = 0; k5 < 5; ++k5)
#pragma unroll
            for (int st = 0; st < 2; ++st) { const bf16x8 pf = pack8(sa[k5], st, inv);
#pragma unroll
                for (int db = 0; db < 2; ++db) { const LAS unsigned char* vp = VL + (32 * db + r) * AT_VROW + (32 * (qb + k5) + 16 * st + 4 * h) * 2;
                    const s16x4 lo = *(const LAS s16x4*)vp, hi = *(const LAS s16x4*)(vp + 16);
                    const bf16x8 vf = __builtin_shufflevector(lo, hi, 0, 1, 2, 3, 4, 5, 6, 7);
                    o[db] = MFMA32(pf, vf, o[db]); } }
#pragma unroll
        for (int db = 0; db < 2; ++db)
#pragma unroll
            for (int i = 0; i < 16; ++i) O[(size_t)(tb + 32 * qb + crow(i, h)) * D + head * HD + 32 * db + r] = (bf16)f2bf(o[db][i]);
    }
    __syncthreads();
}

constexpr int GL_QT = 0, GL_KT = 17408, GL_KET = 34816, GL_VT = 53248, GL_GLR = 90112, GL_TOT = 94208, GL_OT = 0, GL_QROW = 272, GL_TROW = 144, GL_OROW = 260;
__device__ __forceinline__ void gla_decay(const Ctx& C, const Args& a, const bf16* __restrict__ P, int l, int h, int t0, float (&bl)[16], float& blast) {
    LAS float* GLR = (LAS float*)(C.lds + GL_GLR); LAS float* TOT = (LAS float*)(C.lds + GL_TOT);
    const int d = C.tid & 127, cg = C.tid >> 7;
    { const int idx = 2 * C.tid, c = idx >> 4, rr = idx & 15; const unsigned w = *(const unsigned*)(P + (size_t)(t0 + c) * NIN + PC_GL + rr); GLR[idx] = bf2f(w & 0xffffu); GLR[idx + 1] = bf2f(w >> 16); }
    float w2[16];
    const float* gw2 = a.in[I_GW2] + (size_t)l * GRANK * (GH * GDK) + h * GDK + d;
#pragma unroll
    for (int rr = 0; rr < 16; ++rr) w2[rr] = gw2[rr * (GH * GDK)];
    const float gb = a.in[I_GB][l * (GH * GDK) + h * GDK + d];
    __syncthreads();
    float run = 0.f;
#pragma unroll
    for (int i = 0; i < 16; ++i) { const LAS float* g = GLR + (16 * cg + i) * 16; float z = gb;
#pragma unroll
        for (int rr = 0; rr < 16; ++rr) z += g[rr] * w2[rr];
        const float ls = fminf(z, 0.f) - log1pf(expf(-fabsf(z)));
        run += ls * (1.0f / 16.0f); bl[i] = run; }
    TOT[cg * 128 + d] = run;
    __syncthreads();
    float off = 0.f, tot = 0.f;
#pragma unroll
    for (int g = 0; g < 4; ++g) { const float t = TOT[g * 128 + d]; tot += t; if (g < cg) off += t; }
#pragma unroll
    for (int i = 0; i < 16; ++i) bl[i] += off;
    blast = tot;
}
__device__ __forceinline__ void gla_stage_vt(const Ctx& C, const bf16* __restrict__ P, int h, int t0) {
    LAS unsigned char* VT = C.lds + GL_VT;
#pragma unroll
    for (int j = 0; j < 4; ++j) { const int idx = C.tid + 512 * j, c = idx >> 5, e8 = idx & 31;
        const v4u vq = *(const v4u*)(P + (size_t)(t0 + c) * NIN + PC_VG + h * GDV + 8 * e8);
        const unsigned vv[4] = {vq.x, vq.y, vq.z, vq.w};
#pragma unroll
        for (int q = 0; q < 4; ++q) { *(LAS unsigned short*)(VT + (8 * e8 + 2 * q) * GL_TROW + c * 2) = (unsigned short)(vv[q] & 0xffffu); *(LAS unsigned short*)(VT + (8 * e8 + 2 * q + 1) * GL_TROW + c * 2) = (unsigned short)(vv[q] >> 16); } }
}
__device__ __forceinline__ void gla_g1_unit(const Ctx& C, const Args& a, const bf16* __restrict__ P, int l, int ch) {
    const int h = ch & 3, n = (ch >> 2) & (NCHUNK - 1), b = ch >> 10, t0 = b * SEQ + n * GCH;
    float bl[16], blast;
    gla_decay(C, a, P, l, h, t0, bl, blast);
    const int d = C.tid & 127, cg = C.tid >> 7;
    LAS unsigned char* KET = C.lds + GL_KET;
#pragma unroll
    for (int i = 0; i < 16; ++i) { const int c = 16 * cg + i; const float k = bf2f(P[(size_t)(t0 + c) * NIN + PC_KG + h * GDK + d]);
        *(LAS unsigned short*)(KET + d * GL_TROW + c * 2) = (unsigned short)f2bf(k * expf(blast - bl[i])); }
    if (cg == 0) ((float*)(a.ws + WS_DEC))[(size_t)ch * GDK + d] = expf(blast);
    gla_stage_vt(C, P, h, t0);
    __syncthreads();
    const int r = C.lane & 31, hh = C.lane >> 5, w = C.wave;
    const LAS unsigned char* VT = C.lds + GL_VT;
    f32x16 acc[4];
#pragma unroll
    for (int db = 0; db < 4; ++db)
#pragma unroll
        for (int i = 0; i < 16; ++i) acc[db][i] = 0.f;
#pragma unroll
    for (int s = 0; s < 4; ++s) { const bf16x8 af = *(const LAS bf16x8*)(VT + (32 * w + r) * GL_TROW + (16 * s + 8 * hh) * 2);
#pragma unroll
        for (int db = 0; db < 4; ++db) { const bf16x8 bfr = *(const LAS bf16x8*)(KET + (32 * db + r) * GL_TROW + (16 * s + 8 * hh) * 2); acc[db] = MFMA32(af, bfr, acc[db]); } }
    float* kvt = (float*)(a.ws + WS_KVT) + (size_t)ch * (GDV * GDK);
#pragma unroll
    for (int db = 0; db < 4; ++db)
#pragma unroll
        for (int i = 0; i < 16; ++i) kvt[(size_t)(32 * w + crow(i, hh)) * GDK + 32 * db + r] = acc[db][i];
    __syncthreads();
}
__device__ __forceinline__ void gla_scan(const Ctx& C, const Args& a) {
    const float* __restrict__ KVT = (const float*)(a.ws + WS_KVT); const float* __restrict__ DEC = (const float*)(a.ws + WS_DEC); bf16* __restrict__ ST = (bf16*)(a.ws + WS_ST);
    for (int p = blockIdx.x * (NWAVES * 64) + C.tid; p < BATCH * GH * GDV * (GDK / 2); p += C.G * NWAVES * 64) {
        const int dp = p & 63, e = (p >> 6) & 255, bh = p >> 14, b = bh >> 2, h = bh & 3;
        float s0 = 0.f, s1 = 0.f;
#pragma unroll 8
        for (int n = 0; n < NCHUNK; ++n) { const size_t ch = (size_t)(b * NCHUNK + n) * GH + h; const size_t o = (ch * GDV + e) * GDK + 2 * dp;
            *(unsigned*)(ST + o) = pk2(s0, s1);
            const f32x2 kv = *(const f32x2*)(KVT + o), dc = *(const f32x2*)(DEC + ch * GDK + 2 * dp);
            s0 = dc.x * s0 + kv.x; s1 = dc.y * s1 + kv.y; }
    }
}
__device__ __forceinline__ void gla_g3_unit(const Ctx& C, const Args& a, const bf16* __restrict__ P, bf16* __restrict__ O, int l, int ch) {
    const int h = ch & 3, n = (ch >> 2) & (NCHUNK - 1), b = ch >> 10, t0 = b * SEQ + n * GCH;
    float bl[16], blast;
    gla_decay(C, a, P, l, h, t0, bl, blast);
    const int d = C.tid & 127, cg = C.tid >> 7;
    LAS unsigned char* QT = C.lds + GL_QT; LAS unsigned char* KT = C.lds + GL_KT; const LAS unsigned char* VT = C.lds + GL_VT;
#pragma unroll
    for (int i = 0; i < 16; ++i) { const int c = 16 * cg + i; const bf16* row = P + (size_t)(t0 + c) * NIN + h * GDK + d;
        const float q = bf2f(row[PC_QG]), k = bf2f(row[PC_KG]);
        *(LAS unsigned short*)(QT + c * GL_QROW + d * 2) = (unsigned short)f2bf(q * 0.08838834764831845f * expf(bl[i]));
        *(LAS unsigned short*)(KT + c * GL_QROW + d * 2) = (unsigned short)f2bf(k * expf(-bl[i])); }
    gla_stage_vt(C, P, h, t0);
    __syncthreads();
    const int r = C.lane & 31, hh = C.lane >> 5, w = C.wave;
    f32x16 z[2];
#pragma unroll
    for (int i = 0; i < 16; ++i) { z[0][i] = 0.f; z[1][i] = 0.f; }
    { const bf16* st = (const bf16*)(a.ws + WS_ST) + ((size_t)ch * GDV + 32 * w + r) * GDK + 8 * hh;
#pragma unroll
      for (int s = 0; s < 8; ++s) { const bf16x8 sf = *(const bf16x8*)(st + 16 * s);
#pragma unroll
          for (int cb = 0; cb < 2; ++cb) { const bf16x8 qf = *(const LAS bf16x8*)(QT + (32 * cb + r) * GL_QROW + (16 * s + 8 * hh) * 2); z[cb] = MFMA32(qf, sf, z[cb]); } } }
#pragma unroll
    for (int cb = 0; cb < 2; ++cb)
#pragma unroll
        for (int sb = 0; sb <= cb; ++sb) {
            f32x16 at;
#pragma unroll
            for (int i = 0; i < 16; ++i) at[i] = 0.f;
#pragma unroll
            for (int s = 0; s < 8; ++s) { const bf16x8 kf = *(const LAS bf16x8*)(KT + (32 * sb + r) * GL_QROW + (16 * s + 8 * hh) * 2), qf = *(const LAS bf16x8*)(QT + (32 * cb + r) * GL_QROW + (16 * s + 8 * hh) * 2); at = MFMA32(kf, qf, at); }
            if (sb == cb) {
#pragma unroll
                for (int i = 0; i < 16; ++i) at[i] = (crow(i, hh) <= r) ? at[i] : 0.f; }
#pragma unroll
            for (int st = 0; st < 2; ++st) { const bf16x8 pf = pack8(at, st, 1.0f);
                const LAS unsigned char* vp = VT + (32 * w + r) * GL_TROW + (32 * sb + 16 * st + 4 * hh) * 2;
                const s16x4 lo = *(const LAS s16x4*)vp, hi = *(const LAS s16x4*)(vp + 16);
                const bf16x8 vf = __builtin_shufflevector(lo, hi, 0, 1, 2, 3, 4, 5, 6, 7);
                z[cb] = MFMA32(pf, vf, z[cb]); }
        }
    __syncthreads();
    LAS float* OT = (LAS float*)(C.lds + GL_OT);
#pragma unroll
    for (int cb = 0; cb < 2; ++cb)
#pragma unroll
        for (int i = 0; i < 16; ++i) OT[(32 * cb + crow(i, hh)) * GL_OROW + 32 * w + r] = z[cb][i];
    __syncthreads();
    { const int c = C.tid >> 3, es = C.tid & 7;
      const LAS f32x4* orow = (const LAS f32x4*)(OT + c * GL_OROW + 32 * es);
      f32x4 v[8]; float ss = 0.f;
#pragma unroll
      for (int j = 0; j < 8; ++j) { v[j] = orow[j]; ss += (v[j].x * v[j].x + v[j].y * v[j].y) + (v[j].z * v[j].z + v[j].w * v[j].w); }
      ss += shx(ss, 1, C.lane); ss += shx(ss, 2, C.lane); ss += shx(ss, 4, C.lane);
      const float rinv = 1.0f / sqrtf(ss * (1.0f / GDV) + EPS);
      const bf16* rrow = P + (size_t)(t0 + c) * NIN + PC_RG + h * GDV + 32 * es;
      const float* nw = a.in[I_GNORM] + (size_t)l * GDV + 32 * es;
      bf16* orow_g = O + (size_t)(t0 + c) * D + D / 2 + h * GDV + 32 * es;
#pragma unroll
      for (int j = 0; j < 4; ++j) { const v4u rq = *(const v4u*)(rrow + 8 * j); const f32x4 w0 = *(const f32x4*)(nw + 8 * j), w1 = *(const f32x4*)(nw + 8 * j + 4);
          const unsigned rr[4] = {rq.x, rq.y, rq.z, rq.w}; const f32x4 x0 = v[2 * j], x1 = v[2 * j + 1];
          float y[8];
          const float r0 = bf2f(rr[0] & 0xffffu), r1 = bf2f(rr[0] >> 16), r2 = bf2f(rr[1] & 0xffffu), r3 = bf2f(rr[1] >> 16), r4 = bf2f(rr[2] & 0xffffu), r5 = bf2f(rr[2] >> 16), r6 = bf2f(rr[3] & 0xffffu), r7 = bf2f(rr[3] >> 16);
          y[0] = x0.x * rinv * w0.x * pg8::silu_f(r0); y[1] = x0.y * rinv * w0.y * pg8::silu_f(r1); y[2] = x0.z * rinv * w0.z * pg8::silu_f(r2); y[3] = x0.w * rinv * w0.w * pg8::silu_f(r3);
          y[4] = x1.x * rinv * w1.x * pg8::silu_f(r4); y[5] = x1.y * rinv * w1.y * pg8::silu_f(r5); y[6] = x1.z * rinv * w1.z * pg8::silu_f(r6); y[7] = x1.w * rinv * w1.w * pg8::silu_f(r7);
          v4u o; o.x = pk2(y[0], y[1]); o.y = pk2(y[2], y[3]); o.z = pk2(y[4], y[5]); o.w = pk2(y[6], y[7]);
          *(v4u*)(orow_g + 8 * j) = o; } }
    __syncthreads();
}

typedef short v4i16_t __attribute__((ext_vector_type(4)));
__device__ __forceinline__ s16x4 lds_tr16(const LAS unsigned char* p) { return __builtin_bit_cast(s16x4, __builtin_amdgcn_ds_read_tr16_b64_v4i16((LAS v4i16_t*)p)); }
__device__ __forceinline__ bf16x8 cat8(s16x4 lo, s16x4 hi) { return __builtin_shufflevector(lo, hi, 0, 1, 2, 3, 4, 5, 6, 7); }

constexpr int A2_K_OFF = 0, A2_V_OFF = 256 * 144, A2_O_OFF = A2_V_OFF + 256 * 128, A2_OROW = 144, A2_OWAVE = 32 * A2_OROW;
static_assert(A2_O_OFF + 8 * A2_OWAVE <= RING_BYTES, "attention LDS");
__device__ __forceinline__ void attn_unit2(const Ctx& C, const bf16* __restrict__ P, bf16* __restrict__ O, const float* sinks, int unit) {
    const int kv = unit & 1, n = (unit >> 1) & (NBLK - 1), b = unit >> 8;
    const int tb = b * SEQ + n * BLK;
    LAS unsigned char* KL = C.lds + A2_K_OFF; LAS unsigned char* VL = C.lds + A2_V_OFF; LAS unsigned char* OL = C.lds + A2_O_OFF + C.wave * A2_OWAVE;
    const int r = C.lane & 31, h = C.lane >> 5, head = kv * GQA + C.wave;
    v4u kq[4], vq[4];
#pragma unroll
    for (int j = 0; j < 4; ++j) { const int idx = C.tid + 512 * j, key = idx >> 3, part = idx & 7;
        kq[j] = (v4u){0u, 0u, 0u, 0u}; vq[j] = kq[j];
        if (n > 0 || key >= BLK) { const bf16* row = P + (size_t)(tb + key - BLK) * NIN; kq[j] = *(const v4u*)(row + PC_KA + kv * HD + 8 * part); vq[j] = *(const v4u*)(row + PC_VA + kv * HD + 8 * part); } }
    const bf16* qbase = P + (size_t)(tb + r) * NIN + PC_QA + head * HD + 8 * h;
    bf16x8 qf[4], qn[4];
#pragma unroll
    for (int s = 0; s < 4; ++s) { qf[s] = *(const bf16x8*)(qbase + 16 * s); qn[s] = qf[s]; }
#pragma unroll
    for (int j = 0; j < 4; ++j) { const int idx = C.tid + 512 * j, key = idx >> 3, part = idx & 7;
        *(LAS v4u*)(KL + key * 144 + part * 16) = kq[j];
        *(LAS v4u*)(VL + key * 128 + ((part * 16) ^ (((key >> 1) & 1) << 6))) = vq[j]; }
    __syncthreads();
    const float slope = exp2f(-0.5f * (float)(head + 1)), sink = sinks[head];
    const int ibase = r - 4 * h + BLK; const float nb = -slope * (float)ibase;
    const int tq = (C.lane & 15) >> 2, tp = C.lane & 3, tblk = (C.lane >> 4) & 1;
    const int vtr_off = tq * 128 + ((32 * tblk + 8 * tp) ^ (((tq >> 1) & 1) << 6));
#pragma unroll 1
    for (int qb = 0; qb < 4; ++qb) {
        if (qb < 3) {
#pragma unroll
            for (int s = 0; s < 4; ++s) qn[s] = *(const bf16x8*)(qbase + (size_t)(32 * (qb + 1)) * NIN + 16 * s); }
        f32x16 sa[5];
#pragma unroll
        for (int k5 = 0; k5 < 5; ++k5) {
#pragma unroll
            for (int i = 0; i < 16; ++i) sa[k5][i] = 0.f;
#pragma unroll
            for (int s = 0; s < 4; ++s) { const bf16x8 kf = *(const LAS bf16x8*)(KL + (32 * (qb + k5) + r) * 144 + (16 * s + 8 * h) * 2); sa[k5] = MFMA32(kf, qf[s], sa[k5]); } }
        float mx = -INFINITY;
#pragma unroll
        for (int k5 = 0; k5 < 5; ++k5)
#pragma unroll
            for (int i = 0; i < 16; ++i) { const int c = 32 * k5 + (i & 3) + 8 * (i >> 2);
                float v = __builtin_fmaf(sa[k5][i], 0.125f, __builtin_fmaf(slope, (float)c, nb));
                if (k5 == 0) v = (ibase - c < WIN) ? v : -INFINITY;
                if (k5 == 4) v = (ibase >= c) ? v : -INFINITY;
                sa[k5][i] = v; }
        if (n == 0) {
#pragma unroll
            for (int k5 = 0; k5 < 5; ++k5)
#pragma unroll
                for (int i = 0; i < 16; ++i) { const int kj = 32 * (qb + k5) + crow(i, h); if (kj < BLK) sa[k5][i] = -INFINITY; } }
#pragma unroll
        for (int k5 = 0; k5 < 5; ++k5)
#pragma unroll
            for (int i = 0; i < 16; ++i) mx = fmaxf(mx, sa[k5][i]);
        mx = fmaxf(mx, shx(mx, 32, C.lane)); mx = fmaxf(mx, sink);
        float sum = 0.f;
#pragma unroll
        for (int k5 = 0; k5 < 5; ++k5)
#pragma unroll
            for (int i = 0; i < 16; ++i) { const float p = __expf(sa[k5][i] - mx); sa[k5][i] = p; sum += p; }
        sum += shx(sum, 32, C.lane); sum += __expf(sink - mx);
        const float inv = 1.0f / sum;
        f32x16 ot[2];
#pragma unroll
        for (int i = 0; i < 16; ++i) { ot[0][i] = 0.f; ot[1][i] = 0.f; }
#pragma unroll
        for (int k5 = 0; k5 < 5; ++k5)
#pragma unroll
            for (int st = 0; st < 2; ++st) { const bf16x8 pf = pack8(sa[k5], st, inv);
                const int key0 = 32 * (qb + k5) + 16 * st + 4 * h;
#pragma unroll
                for (int db = 0; db < 2; ++db) { const LAS unsigned char* vp = VL + key0 * 128 + (vtr_off ^ (64 * db));
                    const bf16x8 vf = cat8(lds_tr16(vp), lds_tr16(vp + 8 * 128));
                    ot[db] = MFMA32(vf, pf, ot[db]); } }
#pragma unroll
        for (int db = 0; db < 2; ++db)
#pragma unroll
            for (int g = 0; g < 4; ++g) { v2u w; w.x = pk2(ot[db][4 * g], ot[db][4 * g + 1]); w.y = pk2(ot[db][4 * g + 2], ot[db][4 * g + 3]);
                *(LAS v2u*)(OL + r * A2_OROW + (32 * db + 8 * g + 4 * h) * 2) = w; }
#pragma unroll
        for (int j = 0; j < 4; ++j) { const int row = (C.lane >> 3) + 8 * j, part = C.lane & 7;
            const v4u w = *(const LAS v4u*)(OL + row * A2_OROW + part * 16);
            *(v4u*)(O + (size_t)(tb + 32 * qb + row) * D + head * HD + 8 * part) = w; }
#pragma unroll
        for (int s = 0; s < 4; ++s) qf[s] = qn[s];
    }
    __syncthreads();
}

constexpr int G2_QT = 0, G2_KT = 17408, G2_VR = 34816, G2_GLR = 67584, G2_TOT = 71680, G2_QROW = 272, G2_KEROW = 320, G2_OROW = 260;
static_assert(64 * G2_KEROW <= G2_VR && 64 * G2_OROW * 4 <= G2_GLR, "GLA LDS");
__device__ __forceinline__ void gla_decay2(const Ctx& C, const Args& a, unsigned glr, int l, int h, float (&bl)[16], float& blast) {
    LAS float* GLR = (LAS float*)(C.lds + G2_GLR); LAS float* TOT = (LAS float*)(C.lds + G2_TOT);
    const int d = C.tid & 127, cg = C.tid >> 7;
    GLR[2 * C.tid] = bf2f(glr & 0xffffu); GLR[2 * C.tid + 1] = bf2f(glr >> 16);
    float w2[16];
    const float* gw2 = a.in[I_GW2] + (size_t)l * GRANK * (GH * GDK) + h * GDK + d;
#pragma unroll
    for (int rr = 0; rr < 16; ++rr) w2[rr] = gw2[rr * (GH * GDK)];
    const float gb = a.in[I_GB][l * (GH * GDK) + h * GDK + d];
    __syncthreads();
    float run = 0.f;
#pragma unroll
    for (int i = 0; i < 16; ++i) { const LAS f32x4* g = (const LAS f32x4*)(GLR + (16 * cg + i) * 16); float z = gb;
#pragma unroll
        for (int q4 = 0; q4 < 4; ++q4) { const f32x4 gg = g[q4]; z += gg.x * w2[4 * q4] + gg.y * w2[4 * q4 + 1] + gg.z * w2[4 * q4 + 2] + gg.w * w2[4 * q4 + 3]; }
        const float ls = fminf(z, 0.f) - __logf(1.0f + __expf(-fabsf(z)));
        run += ls * (1.0f / 16.0f); bl[i] = run; }
    TOT[cg * 128 + d] = run;
    __syncthreads();
    float off = 0.f, tot = 0.f;
#pragma unroll
    for (int g = 0; g < 4; ++g) { const float t = TOT[g * 128 + d]; tot += t; if (g < cg) off += t; }
#pragma unroll
    for (int i = 0; i < 16; ++i) bl[i] += off;
    blast = tot;
}
__device__ __forceinline__ void gla_g1_unit2(const Ctx& C, const Args& a, const bf16* __restrict__ P, int l, int ch) {
    const int h = ch & 3, n = (ch >> 2) & (NCHUNK - 1), b = ch >> 10, t0 = b * SEQ + n * GCH;
    LAS unsigned char* KE = C.lds + G2_QT; LAS unsigned char* VR = C.lds + G2_VR;
    v4u kq[2], vq[4];
#pragma unroll
    for (int j = 0; j < 2; ++j) { const int idx = C.tid + 512 * j, c = idx >> 4, p16 = idx & 15; kq[j] = *(const v4u*)(P + (size_t)(t0 + c) * NIN + PC_KG + h * GDK + 8 * p16); }
#pragma unroll
    for (int j = 0; j < 4; ++j) { const int idx = C.tid + 512 * j, c = idx >> 5, e8 = idx & 31; vq[j] = *(const v4u*)(P + (size_t)(t0 + c) * NIN + PC_VG + h * GDV + 8 * e8); }
    const unsigned glr = *(const unsigned*)(P + (size_t)(t0 + (C.tid >> 3)) * NIN + PC_GL + 2 * (C.tid & 7));
#pragma unroll
    for (int j = 0; j < 2; ++j) { const int idx = C.tid + 512 * j, c = idx >> 4, p16 = idx & 15; *(LAS v4u*)(KE + c * G2_KEROW + 16 * p16) = kq[j]; }
#pragma unroll
    for (int j = 0; j < 4; ++j) { const int idx = C.tid + 512 * j, c = idx >> 5, e8 = idx & 31; *(LAS v4u*)(VR + c * 512 + ((16 * e8) ^ ((c & 3) << 6))) = vq[j]; }
    float bl[16], blast;
    gla_decay2(C, a, glr, l, h, bl, blast);
    const int d = C.tid & 127, cg = C.tid >> 7;
#pragma unroll
    for (int i = 0; i < 16; ++i) { LAS unsigned short* kp = (LAS unsigned short*)(KE + (16 * cg + i) * G2_KEROW + 2 * d); *kp = (unsigned short)f2bf(bf2f(*kp) * __expf(blast - bl[i])); }
    if (cg == 0) ((float*)(a.ws + WS_DEC))[(size_t)ch * GDK + d] = __expf(blast);
    __syncthreads();
    const int r = C.lane & 31, hh = C.lane >> 5, w = C.wave;
    const int tq = (C.lane & 15) >> 2, tp = C.lane & 3, tblk = (C.lane >> 4) & 1;
    f32x16 acc[4];
#pragma unroll
    for (int db = 0; db < 4; ++db)
#pragma unroll
        for (int i = 0; i < 16; ++i) acc[db][i] = 0.f;
#pragma unroll
    for (int s = 0; s < 4; ++s) { const int c0 = 16 * s + 8 * hh;
        const LAS unsigned char* vp = VR + (c0 + tq) * 512 + ((64 * w + 32 * tblk + 8 * tp) ^ (tq << 6));
        const bf16x8 af = cat8(lds_tr16(vp), lds_tr16(vp + 4 * 512));
#pragma unroll
        for (int db = 0; db < 4; ++db) { const LAS unsigned char* kp = KE + (c0 + tq) * G2_KEROW + 64 * db + 32 * tblk + 8 * tp;
            const bf16x8 bfr = cat8(lds_tr16(kp), lds_tr16(kp + 4 * G2_KEROW));
            acc[db] = MFMA32(af, bfr, acc[db]); } }
    float* kvt = (float*)(a.ws + WS_KVT) + (size_t)ch * (GDV * GDK);
#pragma unroll
    for (int db = 0; db < 4; ++db)
#pragma unroll
        for (int i = 0; i < 16; ++i) kvt[(size_t)(32 * w + crow(i, hh)) * GDK + 32 * db + r] = acc[db][i];
    __syncthreads();
}
__device__ __forceinline__ void gla_g3_unit2(const Ctx& C, const Args& a, const bf16* __restrict__ P, bf16* __restrict__ O, int l, int ch) {
    const int h = ch & 3, n = (ch >> 2) & (NCHUNK - 1), b = ch >> 10, t0 = b * SEQ + n * GCH;
    LAS unsigned char* QT = C.lds + G2_QT; LAS unsigned char* KT = C.lds + G2_KT; LAS unsigned char* VR = C.lds + G2_VR;
    const int r = C.lane & 31, hh = C.lane >> 5, w = C.wave;
    v4u qq[2], kq[2], vq[4];
#pragma unroll
    for (int j = 0; j < 2; ++j) { const int idx = C.tid + 512 * j, c = idx >> 4, p16 = idx & 15; const bf16* row = P + (size_t)(t0 + c) * NIN + h * GDK + 8 * p16; qq[j] = *(const v4u*)(row + PC_QG); kq[j] = *(const v4u*)(row + PC_KG); }
#pragma unroll
    for (int j = 0; j < 4; ++j) { const int idx = C.tid + 512 * j, c = idx >> 5, e8 = idx & 31; vq[j] = *(const v4u*)(P + (size_t)(t0 + c) * NIN + PC_VG + h * GDV + 8 * e8); }
    const unsigned glr = *(const unsigned*)(P + (size_t)(t0 + (C.tid >> 3)) * NIN + PC_GL + 2 * (C.tid & 7));
    bf16x8 sf[8];
    { const bf16* st = (const bf16*)(a.ws + WS_ST) + ((size_t)ch * GDV + 32 * w + r) * GDK + 8 * hh;
#pragma unroll
      for (int s = 0; s < 8; ++s) sf[s] = *(const bf16x8*)(st + 16 * s); }
    v4u rq[4];
    { const bf16* rrow = P + (size_t)(t0 + (C.tid >> 3)) * NIN + PC_RG + h * GDV + 32 * (C.tid & 7);
#pragma unroll
      for (int j = 0; j < 4; ++j) rq[j] = *(const v4u*)(rrow + 8 * j); }
#pragma unroll
    for (int j = 0; j < 2; ++j) { const int idx = C.tid + 512 * j, c = idx >> 4, p16 = idx & 15; *(LAS v4u*)(QT + c * G2_QROW + 16 * p16) = qq[j]; *(LAS v4u*)(KT + c * G2_QROW + 16 * p16) = kq[j]; }
#pragma unroll
    for (int j = 0; j < 4; ++j) { const int idx = C.tid + 512 * j, c = idx >> 5, e8 = idx & 31; *(LAS v4u*)(VR + c * 512 + ((16 * e8) ^ ((c & 3) << 6))) = vq[j]; }
    float bl[16], blast;
    gla_decay2(C, a, glr, l, h, bl, blast);
    { const int d = C.tid & 127, cg = C.tid >> 7;
#pragma unroll
      for (int i = 0; i < 16; ++i) { LAS unsigned short* qp = (LAS unsigned short*)(QT + (16 * cg + i) * G2_QROW + 2 * d); LAS unsigned short* kp = (LAS unsigned short*)(KT + (16 * cg + i) * G2_QROW + 2 * d);
          *qp = (unsigned short)f2bf(bf2f(*qp) * 0.08838834764831845f * __expf(bl[i])); *kp = (unsigned short)f2bf(bf2f(*kp) * __expf(-bl[i])); } }
    __syncthreads();
    const int tq = (C.lane & 15) >> 2, tp = C.lane & 3, tblk = (C.lane >> 4) & 1;
    f32x16 z[2];
#pragma unroll
    for (int i = 0; i < 16; ++i) { z[0][i] = 0.f; z[1][i] = 0.f; }
#pragma unroll
    for (int s = 0; s < 8; ++s)
#pragma unroll
        for (int cb = 0; cb < 2; ++cb) { const bf16x8 qf = *(const LAS bf16x8*)(QT + (32 * cb + r) * G2_QROW + (16 * s + 8 * hh) * 2); z[cb] = MFMA32(qf, sf[s], z[cb]); }
#pragma unroll
    for (int cb = 0; cb < 2; ++cb)
#pragma unroll
        for (int sb = 0; sb <= cb; ++sb) {
            f32x16 at;
#pragma unroll
            for (int i = 0; i < 16; ++i) at[i] = 0.f;
#pragma unroll
            for (int s = 0; s < 8; ++s) { const bf16x8 kf = *(const LAS bf16x8*)(KT + (32 * sb + r) * G2_QROW + (16 * s + 8 * hh) * 2), qf = *(const LAS bf16x8*)(QT + (32 * cb + r) * G2_QROW + (16 * s + 8 * hh) * 2); at = MFMA32(kf, qf, at); }
            if (sb == cb) {
#pragma unroll
                for (int i = 0; i < 16; ++i) at[i] = (crow(i, hh) <= r) ? at[i] : 0.f; }
#pragma unroll
            for (int st = 0; st < 2; ++st) { const bf16x8 pf = pack8(at, st, 1.0f);
                const int c0 = 32 * sb + 16 * st + 4 * hh;
                const LAS unsigned char* vp = VR + (c0 + tq) * 512 + ((64 * w + 32 * tblk + 8 * tp) ^ (tq << 6));
                const bf16x8 vf = cat8(lds_tr16(vp), lds_tr16(vp + 8 * 512));
                z[cb] = MFMA32(pf, vf, z[cb]); }
        }
    __syncthreads();
    LAS float* OT = (LAS float*)(C.lds + G2_QT);
#pragma unroll
    for (int cb = 0; cb < 2; ++cb)
#pragma unroll
        for (int i = 0; i < 16; ++i) OT[(32 * cb + crow(i, hh)) * G2_OROW + 32 * w + r] = z[cb][i];
    __syncthreads();
    { const int c = C.tid >> 3, es = C.tid & 7;
      const LAS f32x4* orow = (const LAS f32x4*)(OT + c * G2_OROW + 32 * es);
      f32x4 v[8]; float ss = 0.f;
#pragma unroll
      for (int j = 0; j < 8; ++j) { v[j] = orow[j]; ss += (v[j].x * v[j].x + v[j].y * v[j].y) + (v[j].z * v[j].z + v[j].w * v[j].w); }
      ss += shx(ss, 1, C.lane); ss += shx(ss, 2, C.lane); ss += shx(ss, 4, C.lane);
      const float rinv = 1.0f / sqrtf(ss * (1.0f / GDV) + EPS);
      const float* nw = a.in[I_GNORM] + (size_t)l * GDV + 32 * es;
      bf16* orow_g = O + (size_t)(t0 + c) * D + D / 2 + h * GDV + 32 * es;
#pragma unroll
      for (int j = 0; j < 4; ++j) { const f32x4 w0 = *(const f32x4*)(nw + 8 * j) * rinv, w1 = *(const f32x4*)(nw + 8 * j + 4) * rinv;
          const f32x4 x0 = v[2 * j], x1 = v[2 * j + 1];
          const float r0 = bf2f(rq[j].x & 0xffffu), r1 = bf2f(rq[j].x >> 16), r2 = bf2f(rq[j].y & 0xffffu), r3 = bf2f(rq[j].y >> 16), r4 = bf2f(rq[j].z & 0xffffu), r5 = bf2f(rq[j].z >> 16), r6 = bf2f(rq[j].w & 0xffffu), r7 = bf2f(rq[j].w >> 16);
          v4u o; o.x = pk2(x0.x * w0.x * pg8::silu_f(r0), x0.y * w0.y * pg8::silu_f(r1)); o.y = pk2(x0.z * w0.z * pg8::silu_f(r2), x0.w * w0.w * pg8::silu_f(r3));
          o.z = pk2(x1.x * w1.x * pg8::silu_f(r4), x1.y * w1.y * pg8::silu_f(r5)); o.w = pk2(x1.z * w1.z * pg8::silu_f(r6), x1.w * w1.w * pg8::silu_f(r7));
          *(v4u*)(orow_g + 8 * j) = o; } }
    __syncthreads();
}

constexpr int G3_NW = 94720 + 17 * 128 * 4;
constexpr int G3_GW = 94720;
constexpr int GG = 8, NGRP = NCHUNK / GG;
constexpr int G3_QT = 0, G3_KT = 17408, G3_VR = 34816, G3_KE = 67584, G3_GLR = 88064, G3_TOT = 92160, G3_DL = 94208, G3_QROW = 272, G3_KEROW = 320, G3_OROW = 260;
static_assert(G3_KE + 64 * G3_KEROW <= G3_GLR && 64 * G3_OROW * 4 <= G3_KE && G3_DL + 512 <= RING_BYTES, "GLA group LDS");
__device__ __forceinline__ void gla_decay3(const Ctx& C, const Args& a, unsigned glr, int l, int h, float (&bl)[16], float& blast) {
    LAS float* GLR = (LAS float*)(C.lds + G3_GLR); LAS float* TOT = (LAS float*)(C.lds + G3_TOT);
    const int d = C.tid & 127, cg = C.tid >> 7;
    GLR[2 * C.tid] = bf2f(glr & 0xffffu); GLR[2 * C.tid + 1] = bf2f(glr >> 16);
    float w2[16];
    const LAS float* GW = (const LAS float*)(C.lds + G3_GW);
#pragma unroll
    for (int rr = 0; rr < 16; ++rr) w2[rr] = GW[rr * 128 + d];
    const float gb = GW[16 * 128 + d];
    __syncthreads();
    float run = 0.f;
#pragma unroll
    for (int i = 0; i < 16; ++i) { const LAS f32x4* g = (const LAS f32x4*)(GLR + (16 * cg + i) * 16); float z = gb;
#pragma unroll
        for (int q4 = 0; q4 < 4; ++q4) { const f32x4 gg = g[q4]; z += gg.x * w2[4 * q4] + gg.y * w2[4 * q4 + 1] + gg.z * w2[4 * q4 + 2] + gg.w * w2[4 * q4 + 3]; }
        const float ls = fminf(z, 0.f) - __logf(1.0f + __expf(-fabsf(z)));
        run += ls * (1.0f / 16.0f); bl[i] = run; }
    TOT[cg * 128 + d] = run;
    __syncthreads();
    float off = 0.f, tot = 0.f;
#pragma unroll
    for (int g = 0; g < 4; ++g) { const float t = TOT[g * 128 + d]; tot += t; if (g < cg) off += t; }
#pragma unroll
    for (int i = 0; i < 16; ++i) bl[i] += off;
    blast = tot;
}
__device__ __forceinline__ void gla_g1_grp(const Ctx& C, const Args& a, const bf16* __restrict__ P, int l, int gu) {
    const int h = gu & 3, grp = (gu >> 2) & (NGRP - 1), b = gu >> 7;
    LAS unsigned char* KE = C.lds + G3_KE; LAS unsigned char* VR = C.lds + G3_VR; LAS float* DL = (LAS float*)(C.lds + G3_DL);
    const int r = C.lane & 31, hh = C.lane >> 5, w = C.wave, d = C.tid & 127, cg = C.tid >> 7;
    const int tq = (C.lane & 15) >> 2, tp = C.lane & 3, tblk = (C.lane >> 4) & 1;
    f32x16 acc[4];
#pragma unroll
    for (int db = 0; db < 4; ++db)
#pragma unroll
        for (int i = 0; i < 16; ++i) acc[db][i] = 0.f;
    { LAS float* GW = (LAS float*)(C.lds + G3_GW);
#pragma unroll
      for (int k = 0; k < 4; ++k) { const int i = C.tid + 512 * k, rr = i >> 7, dd = i & 127; GW[i] = a.in[I_GW2][(size_t)l * GRANK * (GH * GDK) + rr * (GH * GDK) + h * GDK + dd]; }
      if (C.tid < 128) GW[16 * 128 + C.tid] = a.in[I_GB][l * (GH * GDK) + h * GDK + C.tid];
      __syncthreads(); }
    float bsum = 0.f;
    v4u kq[2], vq[4]; unsigned glr;
    { const int t0 = b * SEQ + (grp * GG) * GCH;
#pragma unroll
      for (int i = 0; i < 2; ++i) { const int idx = C.tid + 512 * i, c = idx >> 4, p16 = idx & 15; kq[i] = *(const v4u*)(P + (size_t)(t0 + c) * NIN + PC_KG + h * GDK + 8 * p16); }
#pragma unroll
      for (int i = 0; i < 4; ++i) { const int idx = C.tid + 512 * i, c = idx >> 5, e8 = idx & 31; vq[i] = *(const v4u*)(P + (size_t)(t0 + c) * NIN + PC_VG + h * GDV + 8 * e8); }
      glr = *(const unsigned*)(P + (size_t)(t0 + (C.tid >> 3)) * NIN + PC_GL + 2 * (C.tid & 7)); }
#pragma unroll 1
    for (int j = 0; j < GG; ++j) {
        const int t0 = b * SEQ + (grp * GG + j) * GCH;
#pragma unroll
        for (int i = 0; i < 2; ++i) { const int idx = C.tid + 512 * i, c = idx >> 4, p16 = idx & 15; *(LAS v4u*)(KE + c * G3_KEROW + 16 * p16) = kq[i]; }
#pragma unroll
        for (int i = 0; i < 4; ++i) { const int idx = C.tid + 512 * i, c = idx >> 5, e8 = idx & 31; *(LAS v4u*)(VR + c * 512 + ((16 * e8) ^ ((c & 3) << 6))) = vq[i]; }
        const unsigned glr_cur = glr;
        if (j + 1 < GG) { const int t1 = t0 + GCH;
#pragma unroll
            for (int i = 0; i < 2; ++i) { const int idx = C.tid + 512 * i, c = idx >> 4, p16 = idx & 15; kq[i] = *(const v4u*)(P + (size_t)(t1 + c) * NIN + PC_KG + h * GDK + 8 * p16); }
#pragma unroll
            for (int i = 0; i < 4; ++i) { const int idx = C.tid + 512 * i, c = idx >> 5, e8 = idx & 31; vq[i] = *(const v4u*)(P + (size_t)(t1 + c) * NIN + PC_VG + h * GDV + 8 * e8); }
            glr = *(const unsigned*)(P + (size_t)(t1 + (C.tid >> 3)) * NIN + PC_GL + 2 * (C.tid & 7)); }
        float bl[16], blast;
        gla_decay3(C, a, glr_cur, l, h, bl, blast);
        bsum += blast;
#pragma unroll
        for (int i = 0; i < 16; ++i) { LAS unsigned short* kp = (LAS unsigned short*)(KE + (16 * cg + i) * G3_KEROW + 2 * d); *kp = (unsigned short)f2bf(bf2f(*kp) * __expf(blast - bl[i])); }
        if (cg == 0) DL[d] = __expf(blast);
        __syncthreads();
#pragma unroll
        for (int db = 0; db < 4; ++db) { const float dc = DL[32 * db + r];
#pragma unroll
            for (int i = 0; i < 16; ++i) acc[db][i] *= dc; }
#pragma unroll
        for (int s = 0; s < 4; ++s) { const int c0 = 16 * s + 8 * hh;
            const LAS unsigned char* vp = VR + (c0 + tq) * 512 + ((64 * w + 32 * tblk + 8 * tp) ^ (tq << 6));
            const bf16x8 af = cat8(lds_tr16(vp), lds_tr16(vp + 4 * 512));
#pragma unroll
            for (int db = 0; db < 4; ++db) { const LAS unsigned char* kp = KE + (c0 + tq) * G3_KEROW + 64 * db + 32 * tblk + 8 * tp;
                const bf16x8 bfr = cat8(lds_tr16(kp), lds_tr16(kp + 4 * G3_KEROW));
                acc[db] = MFMA32(af, bfr, acc[db]); } }
        __syncthreads();
    }
    float* kvt = (float*)(a.ws + WS_KVT) + (size_t)gu * (GDV * GDK);
#pragma unroll
    for (int db = 0; db < 4; ++db)
#pragma unroll
        for (int i = 0; i < 16; ++i) kvt[(size_t)(32 * w + crow(i, hh)) * GDK + 32 * db + r] = acc[db][i];
    if (cg == 0) ((float*)(a.ws + WS_DEC))[(size_t)gu * GDK + d] = __expf(bsum);
}
__device__ __forceinline__ void tok0_row(const Ctx& C, const Args& a, const _Float16* hs, const float* w, const float* shv, const float* scv, int bstride) {
    float* u0 = (float*)(a.ws + WS_TOK0);
    if (C.gw < BATCH) { const int b = C.gw, m = b * SEQ;
        const h16x8n* xr = (const h16x8n*)(hs + (size_t)m * D) + C.lane; f32x4 v[8]; float s = 0.f;
#pragma unroll
        for (int j = 0; j < 4; ++j) { const f32x8n f = __builtin_convertvector(xr[64 * j], f32x8n); v[2 * j] = (f32x4){f[0], f[1], f[2], f[3]}; v[2 * j + 1] = (f32x4){f[4], f[5], f[6], f[7]}; }
#pragma unroll
        for (int j = 0; j < 8; ++j) s += (v[j].x * v[j].x + v[j].y * v[j].y) + (v[j].z * v[j].z + v[j].w * v[j].w);
        const float r = 1.0f / sqrtf(wave_sum(s, C.lane) * (1.0f / D) + EPS);
#pragma unroll
        for (int j = 0; j < 8; ++j) { const int col = 8 * (C.lane + 64 * (j >> 1)) + 4 * (j & 1);
            const f32x4 y = v[j] * r * (*(const f32x4*)(w + col) * (*(const f32x4*)(scv + (size_t)b * bstride + col) + 1.0f)) + *(const f32x4*)(shv + (size_t)b * bstride + col);
            *(f32x4*)(u0 + (size_t)b * D + col) = y; } }
}
__device__ __forceinline__ void tok0_qk(const Ctx& C, const Args& a, int l) {
    const float* u0 = (const float*)(a.ws + WS_TOK0); float* qk0 = (float*)(a.ws + WS_TOK0) + BATCH * D;
    for (int id = C.gw; id < BATCH * 2 * GH * GDK; id += C.NGW) { const int b = id >> 10, col = id & 1023;
        const float* wc = a.in[I_WIN] + (size_t)l * D * NINR + PC_QG + col; const float* ur = u0 + (size_t)b * D; float s = 0.f;
        float wv[32];
#pragma unroll
        for (int j = 0; j < 32; ++j) wv[j] = wc[(size_t)(C.lane + 64 * j) * NINR];
#pragma unroll
        for (int j = 0; j < 32; ++j) s += ur[C.lane + 64 * j] * wv[j];
        s = wave_sum(s, C.lane);
        if (C.lane == 0) qk0[(size_t)b * 1024 + col] = s; }
}
constexpr int CW_SDD = 16384 + 64 * 64;
typedef GAS unsigned long long gu64;
__device__ __forceinline__ void sd_store2(float* p, float x, float y) { __hip_atomic_store((gu64*)p, (unsigned long long)__builtin_bit_cast(unsigned, x) | ((unsigned long long)__builtin_bit_cast(unsigned, y) << 32), RLX_AGENT); }
__device__ __forceinline__ void sd_wait_done(const Args& a, int step, unsigned nit, int lane) {
    gu32* p = (gu32*)(a.ws + WS_CTL) + CW_SDD + 64 * step; unsigned* tmo = (unsigned*)(a.ws + WS_CTL) + 4096 + XB_TMO; unsigned sp = 0u;
    for (;;) { const unsigned v = (unsigned)__builtin_amdgcn_readfirstlane((int)__hip_atomic_load(p, RLX_AGENT)); if (v >= nit) break;
        __builtin_amdgcn_s_sleep(2);
        if ((++sp & 255u) == 0u) { if (xb_ld(tmo)) break; if (sp > XB_SPIN_CAP) { atomicAdd(tmo, 1u); break; } } }
    __builtin_amdgcn_fence(__ATOMIC_ACQUIRE, "agent");
}
__device__ __forceinline__ void sd_gemv_item(const Args& a_, int step, const float* W, int ldw, int N, int sl, int ch, float x0, float x1, float* slab, int colbase, int lane) {
    const int c = 256 * ch + 4 * lane; const bool ok = c < N;
    const float* wp = W + (size_t)(sl * 64) * ldw + (ok ? c : 0);
    f32x4 a0 = {0.f, 0.f, 0.f, 0.f}, a1 = a0;
#pragma unroll 32
    for (int kk = 0; kk < 64; ++kk) { const f32x4 w = *(const f32x4*)(wp + (size_t)kk * ldw);
        const float y0 = __builtin_bit_cast(float, __builtin_amdgcn_readlane(__builtin_bit_cast(int, x0), kk)), y1 = __builtin_bit_cast(float, __builtin_amdgcn_readlane(__builtin_bit_cast(int, x1), kk));
        a0 += w * y0; a1 += w * y1; }
    if (ok) { float* q0 = slab + (size_t)(sl * 2 + 0) * SD_NP + colbase + c; float* q1 = slab + (size_t)(sl * 2 + 1) * SD_NP + colbase + c;
        sd_store2(q0, a0.x, a0.y); sd_store2(q0 + 2, a0.z, a0.w); sd_store2(q1, a1.x, a1.y); sd_store2(q1 + 2, a1.z, a1.w); }
}
__device__ __forceinline__ void sd_publish(const Args& a, int step, int n, int lane) {
    asm volatile("s_waitcnt vmcnt(0)" ::: "memory");
    __builtin_amdgcn_wave_barrier();
    if (n > 0 && lane == 0) (void)__hip_atomic_fetch_add((gu32*)(a.ws + WS_CTL) + CW_SDD + 64 * step, (unsigned)n, RLX_AGENT);
    __builtin_amdgcn_wave_barrier();
}
constexpr int CW_SDQ = 16384;
__device__ __forceinline__ int sd_draw(const Args& a, int step, int lane) {
    int it = 0; if (lane == 0) it = (int)__hip_atomic_fetch_add((unsigned*)(a.ws + WS_CTL) + CW_SDQ + 64 * step, 1u, __ATOMIC_RELAXED, __HIP_MEMORY_SCOPE_AGENT);
    return __builtin_amdgcn_readfirstlane(it);
}
__device__ __forceinline__ void sd_gemv_vec(const Ctx& C, const Args& a, int step, const float* W, int K, int N, int ldw, const float* x, float* slab) {
    const int nch = (N + 255) / 256, nit = (K / 64) * nch;
    int n = 0;
    for (;;) { const int it = sd_draw(a, step, C.lane); if (it >= nit) break; const int sl = it / nch, ch = it % nch; ++n;
        sd_gemv_item(a, step, W, ldw, N, sl, ch, x[sl * 64 + C.lane], x[K + sl * 64 + C.lane], slab, 0, C.lane); }
    sd_publish(a, step, n, C.lane);
}
__device__ __forceinline__ void sd_up(const Ctx& C, const Args& a, int step, int l, int f) {
    const float* u = (const float*)(a.ws + WS_SD + SD_U); float* sla = (float*)(a.ws + WS_SD + SD_SLA);
    constexpr int nch = FF / 256, nit1 = (D / 64) * nch;
    int n = 0;
    for (;;) { const int it = sd_draw(a, step, C.lane); if (it >= 2 * nit1) break; const int which = it / nit1, r = it % nit1, sl = r / nch, ch = r % nch;
        const float* W = a.in[f ? (which ? I_F2W3 : I_F2W1) : (which ? I_F1W3 : I_F1W1)] + (size_t)l * D * FF;
        ++n; sd_gemv_item(a, step, W, FF, FF, sl, ch, u[sl * 64 + C.lane], u[D + sl * 64 + C.lane], sla, which * FF, C.lane); }
    sd_publish(a, step, n, C.lane);
}
__device__ __forceinline__ void sd_down(const Ctx& C, const Args& a, int step, int l, int f) {
    const float* sla = (const float*)(a.ws + WS_SD + SD_SLA); float* slb = (float*)(a.ws + WS_SD + SD_SLB);
    const float* W = a.in[f ? I_F2W2 : I_F1W2] + (size_t)l * FF * D;
    constexpr int nch = D / 256, nit = (FF / 64) * nch;
    sd_wait_done(a, step - 1, 2u * (D / 64) * (FF / 256), C.lane);
    int n = 0;
    for (;;) { const int it = sd_draw(a, step, C.lane); if (it >= nit) break; const int sl = it / nch, ch = it % nch, k = sl * 64 + C.lane;
        float xa[2] = {0.f, 0.f}, xb[2] = {0.f, 0.f};
#pragma unroll
        for (int s2 = 0; s2 < D / 64; ++s2) { const float* p0 = sla + (size_t)(s2 * 2) * SD_NP + k;
            xa[0] += p0[0]; xb[0] += p0[FF]; xa[1] += p0[SD_NP]; xb[1] += p0[SD_NP + FF]; }
        const float x0 = xa[0] / (1.0f + expf(-xa[0])) * xb[0], x1 = xa[1] / (1.0f + expf(-xa[1])) * xb[1];
        ++n; sd_gemv_item(a, step, W, D, D, sl, ch, x0, x1, slb, 0, C.lane); }
    sd_publish(a, step, n, C.lane);
}
__device__ __forceinline__ int sd_draw_row(const Ctx& C, const Args& a, int step) {
    LAS int* tk = (LAS int*)(C.lds + 512);
    if (C.tid == 0) tk[0] = (int)__hip_atomic_fetch_add((unsigned*)(a.ws + WS_CTL) + CW_SDQ + 64 * step, 1u, __ATOMIC_RELAXED, __HIP_MEMORY_SCOPE_AGENT);
    __syncthreads();
    const int t = tk[0];
    __syncthreads();
    return t < BATCH ? t : -1;
}
__device__ __forceinline__ void sd_norm(const Ctx& C, const Args& a, int step, int pstep, unsigned pnit, const float* xrow0  , const float* pend, int nsl, const float* gate, float coef, const float* nw, const float* shv, const float* scv, int bstride) {
    const int b = sd_draw_row(C, a, step); if (b < 0) return;
    if (pend) sd_wait_done(a, pstep, pnit, C.lane);
    const int e = 4 * C.tid;
    float* hS = (float*)(a.ws + WS_SD + SD_H) + (size_t)b * D; float* uS = (float*)(a.ws + WS_SD + SD_U) + (size_t)b * D;
    f32x4 h = xrow0 ? *(const f32x4*)(xrow0 + (size_t)b * SEQ * D + e) : *(const f32x4*)(hS + e);
    if (pend) { f32x4 y = {0.f, 0.f, 0.f, 0.f};
#pragma unroll 22
        for (int s2 = 0; s2 < nsl; ++s2) y += *(const f32x4*)(pend + (size_t)(s2 * 2 + b) * SD_NP + e);
        h += y * (*(const f32x4*)(gate + (size_t)b * bstride + e) * coef); }
    *(f32x4*)(hS + e) = h;
    LAS float* red = (LAS float*)(C.lds + 1024);
    const float ss = wave_sum((h.x * h.x + h.y * h.y) + (h.z * h.z + h.w * h.w), C.lane);
    if (C.lane == 0) red[C.wave] = ss;
    __syncthreads();
    float tot = 0.f;
#pragma unroll
    for (int w2 = 0; w2 < NWAVES; ++w2) tot += red[w2];
    const float r = 1.0f / sqrtf(tot * (1.0f / D) + EPS);
    *(f32x4*)(uS + e) = h * r * (*(const f32x4*)(nw + e) * (*(const f32x4*)(scv + (size_t)b * bstride + e) + 1.0f)) + *(const f32x4*)(shv + (size_t)b * bstride + e);
    __syncthreads();
}
__device__ __forceinline__ void sd_win(const Ctx& C, const Args& a, int step, int l) {
    sd_gemv_vec(C, a, step, a.in[I_WIN] + (size_t)l * D * NINR, D, NINR, NINR, (const float*)(a.ws + WS_SD + SD_U), (float*)(a.ws + WS_SD + SD_SLA));
}
__device__ __forceinline__ void sd_wout(const Ctx& C, const Args& a, int step, int l) {
    sd_gemv_vec(C, a, step, a.in[I_WOUT] + (size_t)l * D * D, D, D, D, (const float*)(a.ws + WS_SD + SD_OM), (float*)(a.ws + WS_SD + SD_SLB));
}
__device__ __forceinline__ void sd_mixer(const Ctx& C, const Args& a, int step, int l) {
    const int b = sd_draw_row(C, a, step); if (b < 0) return;
    sd_wait_done(a, step - 1, (unsigned)((D / 64) * ((NINR + 255) / 256)), C.lane);
    const float* sla = (const float*)(a.ws + WS_SD + SD_SLA);
    LAS float* p = (LAS float*)(C.lds + 2048);
    for (int q = C.tid; q < NINR / 4; q += NWAVES * 64) { f32x4 v = {0.f, 0.f, 0.f, 0.f};
#pragma unroll
        for (int s2 = 0; s2 < D / 64; ++s2) v += *(const f32x4*)(sla + (size_t)(s2 * 2 + b) * SD_NP + 4 * q);
        *(LAS f32x4*)(p + 4 * q) = v; }
    __syncthreads();
    float* om = (float*)(a.ws + WS_SD + SD_OM) + (size_t)b * D;
#pragma unroll
    for (int hh2 = 0; hh2 < 2; ++hh2) { const int hq = 2 * C.wave + hh2, kv = hq >> 3;
        const float s0 = wave_sum(p[PC_QA + hq * HD + C.lane] * p[PC_KA + kv * HD + C.lane], C.lane) * 0.125f, sink = a.in[I_SINK][l * NQH + hq];
        const float m = fmaxf(s0, sink), e1 = expf(s0 - m), e2 = expf(sink - m);
        om[hq * HD + C.lane] = e1 / (e1 + e2) * p[PC_VA + kv * HD + C.lane]; }
    if (C.wave < GH) { const int h = C.wave;
        const float a00 = wave_sum(p[PC_QG + h * GDK + C.lane] * p[PC_KG + h * GDK + C.lane] + p[PC_QG + h * GDK + 64 + C.lane] * p[PC_KG + h * GDK + 64 + C.lane], C.lane) * 0.08838834764831845f;
        float o[4], ss = 0.f;
#pragma unroll
        for (int j = 0; j < 4; ++j) { o[j] = a00 * p[PC_VG + h * GDV + C.lane + 64 * j]; ss += o[j] * o[j]; }
        const float rinv = 1.0f / sqrtf(wave_sum(ss, C.lane) * (1.0f / GDV) + EPS);
#pragma unroll
        for (int j = 0; j < 4; ++j) { const int e = C.lane + 64 * j; const float rg = p[PC_RG + h * GDV + e];
            om[D / 2 + h * GDV + e] = o[j] * rinv * a.in[I_GNORM][l * GDV + e] * (rg / (1.0f + expf(-rg))); }
        if (C.lane == 0) ((float*)(a.ws + WS_SD + SD_A00))[b * GH + h] = a00; }
    __syncthreads();
}
__device__ __forceinline__ void gla_scan_grp(const Ctx& C, const Args& a) {
    const float* __restrict__ KVT = (const float*)(a.ws + WS_KVT); const float* __restrict__ DEC = (const float*)(a.ws + WS_DEC); bf16* __restrict__ ST = (bf16*)(a.ws + WS_ST);
    for (int p = blockIdx.x * (NWAVES * 64) + C.tid; p < BATCH * GH * GDV * (GDK / 2); p += C.G * NWAVES * 64) {
        const int dp = p & 63, e = (p >> 6) & 255, bh = p >> 14, b = bh >> 2, h = bh & 3;
        f32x2 kv[NGRP], dc[NGRP];
#pragma unroll
        for (int g = 0; g < NGRP; ++g) { const size_t gu = (size_t)(b * NGRP + g) * GH + h; const size_t o = (gu * GDV + e) * GDK + 2 * dp;
            kv[g] = *(const f32x2*)(KVT + o); dc[g] = *(const f32x2*)(DEC + gu * GDK + 2 * dp); }
        float s0 = 0.f, s1 = 0.f;
#pragma unroll
        for (int g = 0; g < NGRP; ++g) { const size_t gu = (size_t)(b * NGRP + g) * GH + h; const size_t o = (gu * GDV + e) * GDK + 2 * dp;
            *(unsigned*)(ST + o) = pk2(s0, s1);
            s0 = dc[g].x * s0 + kv[g].x; s1 = dc[g].y * s1 + kv[g].y; }
    }
}
__device__ __forceinline__ void gla_g3_grp(const Ctx& C, const Args& a, const bf16* __restrict__ P, bf16* __restrict__ O, int l, int gu) {
    const int h = gu & 3, grp = (gu >> 2) & (NGRP - 1), b = gu >> 7;
    LAS unsigned char* QT = C.lds + G3_QT; LAS unsigned char* KT = C.lds + G3_KT; LAS unsigned char* VR = C.lds + G3_VR; LAS unsigned char* KE = C.lds + G3_KE; LAS float* DL = (LAS float*)(C.lds + G3_DL);
    const int w = C.wave;
    float a00 = 0.f;
    if (grp == 0) a00 = ((const float*)(a.ws + WS_SD + SD_A00))[b * GH + h];
    f32x16 S[4];
    { const int r = C.lane & 31, hh = C.lane >> 5;
      const bf16* st = (const bf16*)(a.ws + WS_ST) + ((size_t)gu * GDV + 32 * w + r) * GDK + 4 * hh;
#pragma unroll
      for (int db = 0; db < 4; ++db)
#pragma unroll
          for (int g = 0; g < 4; ++g) { const v2u x = *(const v2u*)(st + 32 * db + 8 * g);
              S[db][4 * g] = bf2f(x.x & 0xffffu); S[db][4 * g + 1] = bf2f(x.x >> 16); S[db][4 * g + 2] = bf2f(x.y & 0xffffu); S[db][4 * g + 3] = bf2f(x.y >> 16); } }
    { LAS float* GW = (LAS float*)(C.lds + G3_GW);
#pragma unroll
      for (int k = 0; k < 4; ++k) { const int i = C.tid + 512 * k, rr = i >> 7, dd = i & 127; GW[i] = a.in[I_GW2][(size_t)l * GRANK * (GH * GDK) + rr * (GH * GDK) + h * GDK + dd]; }
      if (C.tid < 128) GW[16 * 128 + C.tid] = a.in[I_GB][l * (GH * GDK) + h * GDK + C.tid];
      if (C.tid >= 256) ((LAS float*)(C.lds + G3_NW))[C.tid - 256] = a.in[I_GNORM][(size_t)l * GDV + C.tid - 256];
      __syncthreads(); }
    v4u qq[2], kq[2]; unsigned glr;
#define G3_LOADQK(tt0, tid_) do { \
        glr = *(const unsigned*)(P + (size_t)((tt0) + ((tid_) >> 3)) * NIN + PC_GL + 2 * ((tid_) & 7)); \
        _Pragma("unroll") for (int i = 0; i < 2; ++i) { const int idx = (tid_) + 512 * i, c = idx >> 4, p16 = idx & 15; const bf16* row = P + (size_t)((tt0) + c) * NIN + h * GDK + 8 * p16; qq[i] = *(const v4u*)(row + PC_QG); kq[i] = *(const v4u*)(row + PC_KG); } } while (0)
    { int tid0_ = C.tid; asm volatile("" : "+v"(tid0_)); G3_LOADQK(b * SEQ + grp * GG * GCH, tid0_); }
#pragma unroll 1
    for (int j = 0; j < GG; ++j) {
        const int t0 = b * SEQ + (grp * GG + j) * GCH;
        int tid_ = C.tid; asm volatile("" : "+v"(tid_));
        Ctx C2 = C; C2.tid = tid_; C2.lane = tid_ & 63;
        const int lane = tid_ & 63, r = lane & 31, hh = lane >> 5, d = tid_ & 127, cg = tid_ >> 7;
        const int tq = (lane & 15) >> 2, tp = lane & 3, tblk = (lane >> 4) & 1;
        v4u vq[4], rq[4];
#pragma unroll
        for (int i = 0; i < 4; ++i) { const int idx = tid_ + 512 * i, c = idx >> 5, e8 = idx & 31; vq[i] = *(const v4u*)(P + (size_t)(t0 + c) * NIN + PC_VG + h * GDV + 8 * e8); }
        float bl[16], blast;
        gla_decay3(C2, a, glr, l, h, bl, blast);
#pragma unroll
        for (int i = 0; i < 2; ++i) { const int idx = tid_ + 512 * i, c = idx >> 4, p16 = idx & 15; *(LAS v4u*)(QT + c * G3_QROW + 16 * p16) = qq[i]; *(LAS v4u*)(KT + c * G3_QROW + 16 * p16) = kq[i]; }
        __syncthreads();
#pragma unroll
        for (int i = 0; i < 16; ++i) { LAS unsigned short* qp = (LAS unsigned short*)(QT + (16 * cg + i) * G3_QROW + 2 * d); LAS unsigned short* kp = (LAS unsigned short*)(KT + (16 * cg + i) * G3_QROW + 2 * d);
            const float kraw = bf2f(*kp);
            *qp = (unsigned short)f2bf(bf2f(*qp) * 0.08838834764831845f * __expf(bl[i])); *kp = (unsigned short)f2bf(kraw * __expf(-bl[i]));
            *(LAS unsigned short*)(KE + (16 * cg + i) * G3_KEROW + 2 * d) = (unsigned short)f2bf(kraw * __expf(blast - bl[i])); }
        if (cg == 0) DL[d] = __expf(blast);
#pragma unroll
        for (int i = 0; i < 4; ++i) { const int idx = tid_ + 512 * i, c = idx >> 5, e8 = idx & 31; *(LAS v4u*)(VR + c * 512 + ((16 * e8) ^ ((c & 3) << 6))) = vq[i]; }
        __syncthreads();
        { const bf16* rrow = P + (size_t)(t0 + (tid_ >> 3)) * NIN + PC_RG + h * GDV + 32 * (tid_ & 7);
#pragma unroll
          for (int i = 0; i < 4; ++i) rq[i] = *(const v4u*)(rrow + 8 * i); }
        f32x16 z[2];
#pragma unroll
        for (int i = 0; i < 16; ++i) { z[0][i] = 0.f; z[1][i] = 0.f; }
#pragma unroll
        for (int db = 0; db < 4; ++db)
#pragma unroll
            for (int st = 0; st < 2; ++st) { const bf16x8 sfr = pack8(S[db], st, 1.0f);
#pragma unroll
                for (int cb = 0; cb < 2; ++cb) { const LAS unsigned char* qp = QT + (32 * cb + r) * G3_QROW + (32 * db + 16 * st + 4 * hh) * 2;
                    const bf16x8 qf = cat8(*(const LAS s16x4*)qp, *(const LAS s16x4*)(qp + 16));
                    z[cb] = MFMA32(qf, sfr, z[cb]); } }
#pragma unroll
        for (int cb = 0; cb < 2; ++cb)
#pragma unroll
            for (int sb = 0; sb <= cb; ++sb) {
                f32x16 at;
#pragma unroll
                for (int i = 0; i < 16; ++i) at[i] = 0.f;
#pragma unroll
                for (int s = 0; s < 8; ++s) { const bf16x8 kf = *(const LAS bf16x8*)(KT + (32 * sb + r) * G3_QROW + (16 * s + 8 * hh) * 2), qf = *(const LAS bf16x8*)(QT + (32 * cb + r) * G3_QROW + (16 * s + 8 * hh) * 2); at = MFMA32(kf, qf, at); }
                if (sb == cb) {
#pragma unroll
                    for (int i = 0; i < 16; ++i) at[i] = (crow(i, hh) <= r) ? at[i] : 0.f; }
                if (sb == 0 && cb == 0 && grp == 0 && j == 0 && lane == 0) at[0] = a00;
#pragma unroll
                for (int st = 0; st < 2; ++st) { const bf16x8 pf = pack8(at, st, 1.0f);
                    const int c0 = 32 * sb + 16 * st + 4 * hh;
                    const LAS unsigned char* vp = VR + (c0 + tq) * 512 + ((64 * w + 32 * tblk + 8 * tp) ^ (tq << 6));
                    const bf16x8 vf = cat8(lds_tr16(vp), lds_tr16(vp + 8 * 512));
                    z[cb] = MFMA32(pf, vf, z[cb]); }
            }
        if (j + 1 < GG) {
#pragma unroll
            for (int db = 0; db < 4; ++db)
#pragma unroll
                for (int g = 0; g < 4; ++g) { const f32x4 dc = *(const LAS f32x4*)(DL + 32 * db + 8 * g + 4 * hh);
                    S[db][4 * g] *= dc.x; S[db][4 * g + 1] *= dc.y; S[db][4 * g + 2] *= dc.z; S[db][4 * g + 3] *= dc.w; }
#pragma unroll
            for (int s = 0; s < 4; ++s) { const int c0 = 16 * s + 8 * hh;
                const LAS unsigned char* vp = VR + (c0 + tq) * 512 + ((64 * w + 32 * tblk + 8 * tp) ^ (tq << 6));
                const bf16x8 vfr = cat8(lds_tr16(vp), lds_tr16(vp + 4 * 512));
#pragma unroll
                for (int db = 0; db < 4; ++db) { const LAS unsigned char* kp = KE + (c0 + tq) * G3_KEROW + 64 * db + 32 * tblk + 8 * tp;
                    const bf16x8 kfr = cat8(lds_tr16(kp), lds_tr16(kp + 4 * G3_KEROW));
                    S[db] = MFMA32(kfr, vfr, S[db]); } }
        }
        if (j + 1 < GG) G3_LOADQK(t0 + GCH, tid_);
        __syncthreads();
        LAS float* OT = (LAS float*)(C.lds + G3_QT);
#pragma unroll
        for (int cb = 0; cb < 2; ++cb)
#pragma unroll
            for (int i = 0; i < 16; ++i) OT[(32 * cb + crow(i, hh)) * G3_OROW + 32 * w + r] = z[cb][i];
        __syncthreads();
        { const int c = tid_ >> 3, es = tid_ & 7;
          const LAS f32x4* orow = (const LAS f32x4*)(OT + c * G3_OROW + 32 * es);
          f32x4 v[8]; float ss = 0.f;
#pragma unroll
          for (int i = 0; i < 8; ++i) { v[i] = orow[i]; ss += (v[i].x * v[i].x + v[i].y * v[i].y) + (v[i].z * v[i].z + v[i].w * v[i].w); }
          ss += shx(ss, 1, lane); ss += shx(ss, 2, lane); ss += shx(ss, 4, lane);
          const float rinv = 1.0f / sqrtf(ss * (1.0f / GDV) + EPS);
          const LAS float* nw = (const LAS float*)(C.lds + G3_NW) + 32 * es;
          bf16* orow_g = O + (size_t)(t0 + c) * D + D / 2 + h * GDV + 32 * es;
#pragma unroll
          for (int i = 0; i < 4; ++i) { const f32x4 w0 = *(const LAS f32x4*)(nw + 8 * i) * rinv, w1 = *(const LAS f32x4*)(nw + 8 * i + 4) * rinv;
              const f32x4 x0 = v[2 * i], x1 = v[2 * i + 1];
              const float r0 = bf2f(rq[i].x & 0xffffu), r1 = bf2f(rq[i].x >> 16), r2 = bf2f(rq[i].y & 0xffffu), r3 = bf2f(rq[i].y >> 16), r4 = bf2f(rq[i].z & 0xffffu), r5 = bf2f(rq[i].z >> 16), r6 = bf2f(rq[i].w & 0xffffu), r7 = bf2f(rq[i].w >> 16);
              v4u o; o.x = pk2(x0.x * w0.x * pg8::silu_f(r0), x0.y * w0.y * pg8::silu_f(r1)); o.y = pk2(x0.z * w0.z * pg8::silu_f(r2), x0.w * w0.w * pg8::silu_f(r3));
              o.z = pk2(x1.x * w1.x * pg8::silu_f(r4), x1.y * w1.y * pg8::silu_f(r5)); o.w = pk2(x1.z * w1.z * pg8::silu_f(r6), x1.w * w1.w * pg8::silu_f(r7));
              *(v4u*)(orow_g + 8 * i) = o; } }
        __syncthreads();
    }
}

#ifndef PROBE_MASK
#define PROBE_MASK 0
#endif
#define REP(bit) for (int rep_ = 0; rep_ < (((PROBE_MASK) >> (bit)) & 1) + 1; ++rep_)
#define FRESH_CTX(Cn) Ctx Cn = C; { int t_ = threadIdx.x, g_ = C.gw; asm volatile("" : "+v"(t_), "+s"(g_)); Cn.tid = t_; Cn.lane = t_ & 63; Cn.gw = g_; }
__global__ void __launch_bounds__(NWAVES * 64, 2) hybrid_fwd(Args args) {
    extern __shared__ __attribute__((aligned(16))) unsigned char lds[];
    Ctx C;
    C.lds = (LAS unsigned char*)lds;
    C.tid = threadIdx.x; C.lane = C.tid & 63; C.wave = __builtin_amdgcn_readfirstlane(C.tid >> 6);
    C.G = gridDim.x; { const int bx = blockIdx.x; const int vcu = (C.G % 8 == 0) ? (bx % 8) * (C.G / 8) + bx / 8 : bx; C.gw = vcu * NWAVES + C.wave; C.NGW = C.G * NWAVES; }
    volatile LAS unsigned* MISC = (volatile LAS unsigned*)(C.lds + MISC_OFF);
    unsigned char* ws = args.ws;
    gu32* ctl = (gu32*)(ws + WS_CTL);
    for (int u = C.tid; u < (LDS_BYTES - LDSCTL_OFF) / 4; u += NWAVES * 64) ((LAS unsigned*)(C.lds + LDSCTL_OFF))[u] = 0u;
    __syncthreads();
    XcdBarrier bar; bar.bar = (unsigned*)(ctl + CW_BAR); bar.x = 0; bar.st = nullptr;
    if (MK_N_LAUNCHES == 1) bar = xcd_barrier_post((unsigned*)(ctl + CW_BAR), MISC + 8);
    const int lo = args.ph_lo, hi = args.ph_hi;
#define IN(k) (lo <= (k) && (k) < hi)
#define SEAM(k) do { if (MK_N_LAUNCHES == 1) { if (IN((k) + 1)) xcd_barrier(bar); } } while (0)
#define SEAM_SIDE(k, SIDE) do { if (MK_N_LAUNCHES == 1 && IN((k) + 1)) xcd_barrier_side(bar, [&]() { SIDE; }); else { SIDE; } } while (0)

    const float* modp = (const float*)(ws + WS_MOD); const float* fmodp = (const float*)(ws + WS_FMOD);
    bf16* U = (bf16*)(ws + WS_U); bf16* HID = (bf16*)(ws + WS_HID); bf16* P = (bf16*)(ws + WS_HID); bf16* OMIX = (bf16*)(ws + WS_OMIX); _Float16* HS = (_Float16*)(ws + WS_H); signed char* U8 = (signed char*)(ws + WS_U); float* SROW = (float*)(ws + WS_SROW);

    if (IN(0)) {
#ifndef DIS_P0MOD
 REP(0) { FRESH_CTX(Cp) p0_mod(Cp, args); }
#endif
 { FRESH_CTX(Cp) p0_phase_a(Cp, args, MISC + 16); }
 SEAM(0); }

#pragma unroll 1
    for (int l = 0; l < DEPTH; ++l) {
        const int pb = 1 + 12 * l;
        const float* modl = modp + (size_t)l * BATCH * NMOD * D;
        unsigned char* wl = ws + WS_W + (size_t)l * W_LAYER;
#pragma unroll 1
        for (int f = 0; f < 2; ++f) {
            const int pf = pb + (f ? 9 : 0), sub = f ? 2 : 0;
            if (IN(pf + 0)) {
                const float* src = (l == 0 && f == 0) ? args.in[I_X] : args.out;
#ifndef DIS_NORM
                if (l == 0 && f == 0) { REP(1) { FRESH_CTX(Cp) norm_q8<true>(Cp, args.in[I_X], args.in[I_NFFN1], modl + 0 * D, modl + 1 * D, NMOD * D, U8, SROW); } }
                else { REP(1) { FRESH_CTX(Cp) norm_q8<false>(Cp, HS, args.in[f ? I_NFFN2 : I_NFFN1] + (size_t)l * D, modl + (3 * sub + 0) * D, modl + (3 * sub + 1) * D, NMOD * D, U8, SROW); } }
#endif
                if (!(l == DEPTH - 1 && f == 1)) { FRESH_CTX(Cs)
                    const int st = l * 10 + (f ? 7 : 0);
                    if (f == 0) { if (l == 0) sd_norm(Cs, args, st, -1, 0u, args.in[I_X], nullptr, 0, nullptr, 0.f, args.in[I_NFFN1], modl + 0 * D, modl + 1 * D, NMOD * D);
                                  else sd_norm(Cs, args, st, (l - 1) * 10 + 9, (unsigned)((FF / 64) * (D / 256)), nullptr, (const float*)(ws + WS_SD + SD_SLB), FF / 64, modl - (size_t)BATCH * NMOD * D + 8 * D, 0.5f, args.in[I_NFFN1] + (size_t)l * D, modl + 0 * D, modl + 1 * D, NMOD * D); }
                    else sd_norm(Cs, args, st, l * 10 + 6, (unsigned)((D / 64) * (D / 256)), nullptr, (const float*)(ws + WS_SD + SD_SLB), D / 64, modl + 5 * D, 1.0f, args.in[I_NFFN2] + (size_t)l * D, modl + 6 * D, modl + 7 * D, NMOD * D); }
                SEAM(pf + 0);
            }
            if (IN(pf + 1)) {
                pg8::Gemm g{(const bf16*)U8, (const bf16*)(wl + f * W_FFN), M, NUP, D / 2};
                pg8::StaticOrder S; S.init(M, NUP, C.G, (int)blockIdx.x);
                pg8::EpiSwiGLU8 E{HID, FF, SROW, (const float*)(ws + WS_SCOL) + (size_t)(l * 2 + f) * NUP};
#ifndef DIS_UP
                REP(2) pg8::gemm_phase<pg8::EpiSwiGLU8, pg8::StaticOrder, GEMM_ALIGN, GEMM_SP2>(C.lds + RING_OFF, g, S, E);
#endif
                SEAM_SIDE(pf + 1, if (!(l == DEPTH - 1 && f == 1)) { FRESH_CTX(Cs) sd_up(Cs, args, l * 10 + (f ? 8 : 1), l, f); });
            }
            if (IN(pf + 2)) {
                pg8::Gemm g{HID, (const bf16*)(wl + f * W_FFN + W_DN), M, D, FF}; DN_ORDER S; S.init(M, D, C.G, (int)blockIdx.x);
                if (l == 0 && f == 0) { pg8::EpiResidH<true, true> E{args.in[I_X], HS, modl + (3 * sub + 2) * D, D, NMOD * D};
                    pg8::gemm_phase<pg8::EpiResidH<true, true>, DN_ORDER, GEMM_ALIGN, GEMM_SP2>(C.lds + RING_OFF, g, S, E); }
                else { pg8::EpiResidH<false, true> E{HS, HS, modl + (3 * sub + 2) * D, D, NMOD * D};
                    pg8::gemm_phase<pg8::EpiResidH<false, true>, DN_ORDER, GEMM_ALIGN, GEMM_SP2>(C.lds + RING_OFF, g, S, E); }
                SEAM_SIDE(pf + 2, if (!(l == DEPTH - 1 && f == 1)) { FRESH_CTX(Cs) sd_down(Cs, args, l * 10 + (f ? 9 : 2), l, f); });
            }
            if (f == 0) {
                if (IN(pb + 3)) {
#ifndef DIS_NORM
                    REP(1) { FRESH_CTX(Cp) norm_phase_h<false>(Cp, HS, args.in[I_NMIX] + (size_t)l * D, modl + 3 * D, modl + 4 * D, NMOD * D, U, nullptr); }
#endif
                    { FRESH_CTX(Cs) sd_norm(Cs, args, l * 10 + 3, l * 10 + 2, (unsigned)((FF / 64) * (D / 256)), nullptr, (const float*)(ws + WS_SD + SD_SLB), FF / 64, modl + 2 * D, 0.5f, args.in[I_NMIX] + (size_t)l * D, modl + 3 * D, modl + 4 * D, NMOD * D); }
                    SEAM(pb + 3);
                }
                if (IN(pb + 4)) {
                    pg8::Gemm g{U, (const bf16*)(wl + W_IN), M, NIN, D}; pg8::StaticOrder S; S.init(M, NIN, C.G, (int)blockIdx.x);
                    pg8::EpiBf16 E{P, NIN};
#ifndef DIS_IN
                    REP(3) pg8::gemm_phase<pg8::EpiBf16, pg8::StaticOrder, GEMM_ALIGN, GEMM_SP2>(C.lds + RING_OFF, g, S, E);
#endif
                    SEAM_SIDE(pb + 4, { FRESH_CTX(Cs) sd_win(Cs, args, l * 10 + 4, l); });
                }
                if (IN(pb + 5)) {
                    #ifndef DIS_ATTN
                    REP(4) { FRESH_CTX(Cp) for (int u = blockIdx.x; u < BATCH * NBLK * NKV; u += C.G) attn_unit2(Cp, P, OMIX, args.in[I_SINK] + l * NQH, u); }
#endif
                    #ifndef DIS_G1
                    REP(5) { FRESH_CTX(Cp) for (int gu = blockIdx.x; gu < BATCH * NGRP * GH; gu += C.G) gla_g1_grp(Cp, args, P, l, gu); }
#endif
                    { FRESH_CTX(Cs) sd_mixer(Cs, args, l * 10 + 5, l); }
                    SEAM(pb + 5);
                }
                if (IN(pb + 6)) {
#ifndef DIS_SCAN
 REP(6) { FRESH_CTX(Cp) gla_scan_grp(Cp, args); }
#endif
 SEAM(pb + 6); }
                if (IN(pb + 7)) {
                    #ifndef DIS_G3
                    REP(7) { FRESH_CTX(Cp) for (int gu = blockIdx.x; gu < BATCH * NGRP * GH; gu += C.G) gla_g3_grp(Cp, args, P, OMIX, l, gu); }
#endif
                    SEAM(pb + 7);
                }
                if (IN(pb + 8)) {
                    pg8::Gemm g{OMIX, (const bf16*)(wl + W_OUT), M, D, D}; pg8::StaticOrder S; S.init(M, D, C.G, (int)blockIdx.x);
                    pg8::EpiResidH<false, false> E{HS, HS, modl + 5 * D, D, NMOD * D};
                    pg8::gemm_phase<pg8::EpiResidH<false, false>, pg8::StaticOrder, GEMM_ALIGN, GEMM_SP2>(C.lds + RING_OFF, g, S, E);
                    SEAM_SIDE(pb + 8, if (l < DEPTH - 1) { FRESH_CTX(Cs) sd_wout(Cs, args, l * 10 + 6, l); });
                }
            }
        }
    }
#ifndef DIS_NORM
    if (IN(NPH - 1)) { FRESH_CTX(Cp) norm_phase_h<true>(Cp, HS, args.in[I_FNORM], fmodp, fmodp + D, 2 * D, nullptr, args.out); }
#endif
#ifdef PROBE_WAIT
    {
        if (threadIdx.x == 0) { const unsigned w = MISC[12]; atomicAdd((unsigned*)(ctl + 8192), w); atomicMax((unsigned*)(ctl + 8193), ~0u - w); atomicMax((unsigned*)(ctl + 8194), w); atomicAdd((unsigned*)(ctl + 8195), MISC[13]); if (blockIdx.x == 0) atomicAdd((unsigned*)(ctl + 8196), MISC[15]); }
        xcd_barrier(bar);
        if (threadIdx.x == 0) {
            const unsigned sum = __hip_atomic_load((unsigned*)(ctl + 8192), RLX_AGENT), mn = ~0u - __hip_atomic_load((unsigned*)(ctl + 8193), RLX_AGENT), mx = __hip_atomic_load((unsigned*)(ctl + 8194), RLX_AGENT);
            const unsigned v = PROBE_WSEL == 0 ? sum / gridDim.x : PROBE_WSEL == 1 ? mn : PROBE_WSEL == 2 ? mx : PROBE_WSEL == 3 ? __hip_atomic_load((unsigned*)(ctl + 8195), RLX_AGENT) / 8 : __hip_atomic_load((unsigned*)(ctl + 8196), RLX_AGENT);
            const unsigned long long t0 = wall_clock64();
            while (wall_clock64() - t0 < (unsigned long long)v * PROBE_WAIT) __builtin_amdgcn_s_sleep(8);
        }
        __syncthreads();
    }
#endif
#undef IN
#undef SEAM
}

extern "C" void kernel_launch(void* const* d_in, const int* in_sizes, int n_in, void* d_out, int out_size, void* d_ws, size_t ws_size, hipStream_t stream) {
    static int grid = 0;
    if (grid == 0) {
        if (n_in != 22 || in_sizes[0] != M * D || out_size != M * D || ws_size < WS_END) { fprintf(stderr, "kernel_launch: unexpected shapes (n_in %d, in0 %d, out %d, ws %zu); nothing launched\n", n_in, n_in > 0 ? in_sizes[0] : -1, out_size, ws_size); grid = -1; return; }
        int dev = 0, cus = 0, per_cu = 0;
        if (hipGetDevice(&dev) != hipSuccess || hipDeviceGetAttribute(&cus, hipDeviceAttributeMultiprocessorCount, dev) != hipSuccess) { grid = -1; return; }
        if (hipFuncSetAttribute((const void*)hybrid_fwd, hipFuncAttributeMaxDynamicSharedMemorySize, LDS_BYTES) != hipSuccess) { fprintf(stderr, "kernel_launch: hipFuncSetAttribute failed\n"); grid = -1; return; }
        if (hipOccupancyMaxActiveBlocksPerMultiprocessor(&per_cu, (const void*)hybrid_fwd, NWAVES * 64, LDS_BYTES) != hipSuccess || per_cu < 1) { fprintf(stderr, "kernel_launch: occupancy query says %d blocks per CU; nothing launched\n", per_cu); (void)hipGetLastError(); grid = -1; return; }
        grid = cus;
    }
    if (grid < 0) return;
    if (hipMemsetAsync((char*)d_ws + WS_CTL, 0, CTL_ZERO_BYTES, stream) != hipSuccess) return;
    Args a{};
    for (int i = 0; i < 22; ++i) a.in[i] = (const float*)d_in[i];
    a.out = (float*)d_out; a.ws = (unsigned char*)d_ws; a.li = 0; a.pad = 0;
    if (MK_N_LAUNCHES == 1) { a.ph_lo = 0; a.ph_hi = NPH; hipLaunchKernelGGL(hybrid_fwd, dim3(grid), dim3(NWAVES * 64), LDS_BYTES, stream, a); }
    else for (int p = 0; p < NPH; ++p) { a.ph_lo = p; a.ph_hi = p + 1; hipLaunchKernelGGL(hybrid_fwd, dim3(grid), dim3(NWAVES * 64), LDS_BYTES, stream, a); }
}
```

```cpp
#include <hip/hip_runtime.h>
#include <cstdio>
#include <cstdint>
constexpr int BATCH = 2, SEQ = 16384, D = 2048, DEPTH = 4, M = BATCH * SEQ, FF = 5632, NUP = 2 * FF, NINR = 4368, NIN = 4608;
constexpr int NQH = 16, NKV = 2, HD = 64, GQA = 8, WIN = 128, BLK = 128, NBLK = SEQ / BLK;
constexpr int GH = 4, GDK = 128, GDV = 256, GRANK = 16, GCH = 64, NCHUNK = SEQ / GCH;
constexpr int NMOD = 9;
constexpr float EPS = 1e-6f;
constexpr int PC_QA = 0, PC_KA = 1024, PC_VA = 1152, PC_QG = 1280, PC_KG = 1792, PC_VG = 2304, PC_RG = 3328, PC_GL = 4352;
#ifndef GEMM_WGM
#define GEMM_WGM 8
#endif
namespace pg8 {
#define PG8_LAS __attribute__((address_space(3)))
typedef unsigned short bf16_t;
typedef short bf16x8 __attribute__((ext_vector_type(8)));
typedef float f32x4 __attribute__((ext_vector_type(4)));
typedef unsigned u32x4 __attribute__((ext_vector_type(4)));
typedef int i32x4 __attribute__((ext_vector_type(4)));
constexpr int BM = 256, BK = 64, HALF = 128, HTB = HALF * BK * 2  , STAGE_BYTES = 8 * HTB, NXCD = 8, WGM = GEMM_WGM;

__host__ __device__ __forceinline__ int lds_byte(int r, int c) { const int st = (r >> 4) * 2 + (c >> 5), rr = r & 15, cc = c & 31, ob = rr * 64 + cc * 2; return st * 1024 + (ob ^ (((ob >> 9) & 1) << 5)); }
__host__ __device__ __forceinline__ void stage_rc(int b, int& R, int& C) { const int st = b / 1024, sb = b % 1024, swz = sb ^ (((sb >> 9) & 1) << 5); R = (st >> 1) * 16 + swz / 64; C = (st & 1) * 32 + (swz % 64) / 2; }
__host__ __device__ __forceinline__ int perm32(int rho) { const int n = rho >> 4, i = rho & 15; return 8 * (i >> 2) + 4 * n + (i & 3); }

struct Unit { int pm, pn; };
struct Gemm { const bf16_t* A; const bf16_t* Bt; int M, N, K; };

struct StaticOrder {
    int nM, nN, nwg, G, c;
    __host__ __device__ void init(int M, int N, int G_, int c_) { nM = M / BM; nN = N / BM; nwg = nM * nN; G = G_; c = c_; }
    __host__ __device__ bool next(int i, Unit& u) const {
        const long L = (long)i * G + c; if (L >= nwg) return false;
        int wgid = (int)L; { const int q = nwg / NXCD, r = nwg % NXCD, xcd = wgid % NXCD, off = wgid / NXCD; wgid = (xcd < r ? xcd * (q + 1) : r * (q + 1) + (xcd - r) * q) + off; }
        const int nig = WGM * nN, gid = wgid / nig, fm = gid * WGM, gsz = (nM - fm) < WGM ? (nM - fm) : WGM;
        u.pm = fm + ((wgid % nig) % gsz); u.pn = (wgid % nig) / gsz; return true;
    }
    __device__ __forceinline__ void a_ready(const Unit&) const {}
    __device__ __forceinline__ void done(const Unit&) const {}
};
struct StaticOrderRev : StaticOrder {
    __host__ __device__ bool next(int i, Unit& u) const { if (!StaticOrder::next(i, u)) return false; u.pm = nM - 1 - u.pm; return true; }
};

__device__ __forceinline__ unsigned cvt_pk_bf16(float lo, float hi) { unsigned r; asm volatile("v_cvt_pk_bf16_f32 %0, %1, %2" : "=v"(r) : "v"(lo), "v"(hi)); return r; }
typedef float f32x2 __attribute__((ext_vector_type(2)));
typedef __bf16 bf16x2n __attribute__((ext_vector_type(2)));
__device__ __forceinline__ unsigned cvtpk(float lo, float hi) { f32x2 v = {lo, hi}; bf16x2n b = __builtin_convertvector(v, bf16x2n); return __builtin_bit_cast(unsigned, b); }
__device__ __forceinline__ float silu_f(float x) { return x * __builtin_amdgcn_rcpf(1.0f + __builtin_amdgcn_exp2f(-1.44269504089f * x)); }

struct EpiBf16 {
    static constexpr bool PERM = true, AFTER_DRAIN = false;
    bf16_t* O; int ldc;
    __device__ __forceinline__ void operator()(const f32x4 (&acc)[2][2][4][2], const Unit& u, int wr, int wc, int fr, int fq) const {
        const int row0 = u.pm * BM + wr * 64 + fr, col0 = u.pn * BM + wc * 32 + 8 * fq;
#pragma unroll
        for (int ai = 0; ai < 2; ++ai)
#pragma unroll
            for (int m = 0; m < 4; ++m) { bf16_t* rowp = O + (size_t)(row0 + ai * HALF + m * 16) * ldc + col0;
#pragma unroll
                for (int bj = 0; bj < 2; ++bj) { const f32x4 v0 = acc[ai][bj][m][0], v1 = acc[ai][bj][m][1];
                    u32x4 w; w.x = cvtpk(v0[0], v0[1]); w.y = cvtpk(v0[2], v0[3]); w.z = cvtpk(v1[0], v1[1]); w.w = cvtpk(v1[2], v1[3]);
                    *(u32x4*)(rowp + bj * HALF) = w; } }
    }
};
struct EpiSwiGLU {
    static constexpr bool PERM = true, AFTER_DRAIN = false;
    bf16_t* O; int ldc;
    __device__ __forceinline__ void operator()(const f32x4 (&acc)[2][2][4][2], const Unit& u, int wr, int wc, int fr, int fq) const {
        const int row0 = u.pm * BM + wr * 64 + fr, col0 = u.pn * HALF + wc * 32 + 8 * fq;
#pragma unroll
        for (int ai = 0; ai < 2; ++ai)
#pragma unroll
            for (int m = 0; m < 4; ++m) { bf16_t* rowp = O + (size_t)(row0 + ai * HALF + m * 16) * ldc + col0;
                const f32x4 g0 = acc[ai][0][m][0], g1 = acc[ai][0][m][1], u0 = acc[ai][1][m][0], u1 = acc[ai][1][m][1];
                float r[8];
#pragma unroll
                for (int i = 0; i < 4; ++i) { r[i] = silu_f(g0[i]) * u0[i]; r[4 + i] = silu_f(g1[i]) * u1[i]; }
                u32x4 w; w.x = cvtpk(r[0], r[1]); w.y = cvtpk(r[2], r[3]); w.z = cvtpk(r[4], r[5]); w.w = cvtpk(r[6], r[7]);
                *(u32x4*)rowp = w; }
    }
};
struct EpiResid {
    static constexpr bool PERM = false, AFTER_DRAIN = false;
    const float* base; float* out; int ldc; const float* gate; int gstride; float coef;
    __device__ __forceinline__ void operator()(const f32x4 (&acc)[2][2][4][2], const Unit& u, int wr, int wc, int fr, int fq) const {
        const int row0 = u.pm * BM + wr * 64 + fr, col0 = u.pn * BM + wc * 32 + 4 * fq;
        const float* gp = gate + (size_t)((u.pm * BM >= SEQ) ? 1 : 0) * gstride + col0;
        f32x4 gv[2][2];
#pragma unroll
        for (int bj = 0; bj < 2; ++bj)
#pragma unroll
            for (int n = 0; n < 2; ++n) gv[bj][n] = *(const f32x4*)(gp + bj * HALF + n * 16) * coef;
#pragma unroll
        for (int ai = 0; ai < 2; ++ai)
#pragma unroll
            for (int m = 0; m < 4; ++m) { const size_t off = (size_t)(row0 + ai * HALF + m * 16) * ldc + col0;
#pragma unroll
                for (int bj = 0; bj < 2; ++bj)
#pragma unroll
                    for (int n = 0; n < 2; ++n) { const f32x4 bs = *(const f32x4*)(base + off + bj * HALF + n * 16);
                        *(f32x4*)(out + off + bj * HALF + n * 16) = bs + gv[bj][n] * acc[ai][bj][m][n]; }
                asm volatile("" ::: "memory"); }
    }
};
struct EpiSwiGLU8 {
    typedef i32x4 acc_t;
    static constexpr bool PERM = true, AFTER_DRAIN = false;
    bf16_t* O; int ldc; const float* srow; const float* scol;
    __device__ __forceinline__ void operator()(const i32x4 (&acc)[2][2][4][2], const Unit& u, int wr, int wc, int fr, int fq) const {
        const int row0 = u.pm * BM + wr * 64 + fr, col0 = u.pn * HALF + wc * 32 + 8 * fq;
        float rs[2][4];
#pragma unroll
        for (int ai = 0; ai < 2; ++ai)
#pragma unroll
            for (int m = 0; m < 4; ++m) rs[ai][m] = srow[row0 + ai * HALF + m * 16];
        const float* sp = scol + u.pn * BM + wc * 32 + 8 * fq;
        const f32x4 sg0 = *(const f32x4*)(sp), sg1 = *(const f32x4*)(sp + 4), su0 = *(const f32x4*)(sp + HALF), su1 = *(const f32x4*)(sp + HALF + 4);
#pragma unroll
        for (int ai = 0; ai < 2; ++ai)
#pragma unroll
            for (int m = 0; m < 4; ++m) { bf16_t* rowp = O + (size_t)(row0 + ai * HALF + m * 16) * ldc + col0; const float r_ = rs[ai][m];
                const f32x4 g0 = __builtin_convertvector(acc[ai][0][m][0], f32x4) * (sg0 * r_), g1 = __builtin_convertvector(acc[ai][0][m][1], f32x4) * (sg1 * r_);
                const f32x4 u0 = __builtin_convertvector(acc[ai][1][m][0], f32x4) * (su0 * r_), u1 = __builtin_convertvector(acc[ai][1][m][1], f32x4) * (su1 * r_);
                float r[8];
#pragma unroll
                for (int i = 0; i < 4; ++i) { r[i] = silu_f(g0[i]) * u0[i]; r[4 + i] = silu_f(g1[i]) * u1[i]; }
                u32x4 w; w.x = cvtpk(r[0], r[1]); w.y = cvtpk(r[2], r[3]); w.z = cvtpk(r[4], r[5]); w.w = cvtpk(r[6], r[7]);
                *(u32x4*)rowp = w; }
    }
};
typedef _Float16 h16x8 __attribute__((ext_vector_type(8)));
typedef float f32x8 __attribute__((ext_vector_type(8)));
template <bool BASE_F32, bool HALF_COEF> struct EpiResidH {
    static constexpr bool PERM = true, AFTER_DRAIN = false;
    const void* base; _Float16* out; const float* gate; int ldc, gstride;
    __device__ __forceinline__ void operator()(const f32x4 (&acc)[2][2][4][2], const Unit& u, int wr, int wc, int fr, int fq) const {
        constexpr float coef = HALF_COEF ? 0.5f : 1.0f;
        const int row0 = u.pm * BM + wr * 64 + fr, col0 = u.pn * BM + wc * 32 + 8 * fq;
        const float* gp = gate + (size_t)((u.pm * BM >= SEQ) ? 1 : 0) * gstride + col0;
        f32x4 gv[2][2];
#pragma unroll
        for (int bj = 0; bj < 2; ++bj)
#pragma unroll
            for (int n = 0; n < 2; ++n) gv[bj][n] = *(const f32x4*)(gp + bj * HALF + 4 * n) * coef;
        if constexpr (!BASE_F32) {
            h16x8 hb[2][4][2];
#pragma unroll
            for (int ai = 0; ai < 2; ++ai)
#pragma unroll
                for (int m = 0; m < 4; ++m) { const size_t off = (size_t)row0 * D + col0 + (size_t)(ai * HALF + m * 16) * D;
#pragma unroll
                    for (int bj = 0; bj < 2; ++bj) hb[ai][m][bj] = *(const h16x8*)((const _Float16*)base + off + bj * HALF); }
#pragma unroll
            for (int ai = 0; ai < 2; ++ai)
#pragma unroll
                for (int m = 0; m < 4; ++m) { const size_t off = (size_t)row0 * D + col0 + (size_t)(ai * HALF + m * 16) * D;
#pragma unroll
                    for (int bj = 0; bj < 2; ++bj) { const f32x8 fb = __builtin_convertvector(hb[ai][m][bj], f32x8);
                        const f32x4 o0 = (f32x4){fb[0], fb[1], fb[2], fb[3]} + gv[bj][0] * acc[ai][bj][m][0], o1 = (f32x4){fb[4], fb[5], fb[6], fb[7]} + gv[bj][1] * acc[ai][bj][m][1];
                        const f32x8 o = {o0[0], o0[1], o0[2], o0[3], o1[0], o1[1], o1[2], o1[3]};
                        *(h16x8*)(out + off + bj * HALF) = __builtin_convertvector(o, h16x8); } }
        } else
#pragma unroll
        for (int ai = 0; ai < 2; ++ai) {
            f32x4 bb[4][2][2];
#pragma unroll
            for (int m = 0; m < 4; ++m) { const size_t off = (size_t)(row0 + ai * HALF + m * 16) * ldc + col0;
#pragma unroll
                for (int bj = 0; bj < 2; ++bj) {
                    if (BASE_F32) { const float* bp = (const float*)base + off + bj * HALF; bb[m][bj][0] = *(const f32x4*)bp; bb[m][bj][1] = *(const f32x4*)(bp + 4); }
                    else { const h16x8 hb = *(const h16x8*)((const _Float16*)base + off + bj * HALF); const f32x8 fb = __builtin_convertvector(hb, f32x8);
                        bb[m][bj][0] = (f32x4){fb[0], fb[1], fb[2], fb[3]}; bb[m][bj][1] = (f32x4){fb[4], fb[5], fb[6], fb[7]}; } } }
#pragma unroll
            for (int m = 0; m < 4; ++m) { const size_t off = (size_t)(row0 + ai * HALF + m * 16) * ldc + col0;
#pragma unroll
                for (int bj = 0; bj < 2; ++bj) {
                    const f32x4 o0 = bb[m][bj][0] + gv[bj][0] * acc[ai][bj][m][0], o1 = bb[m][bj][1] + gv[bj][1] * acc[ai][bj][m][1];
                    const f32x8 o = {o0[0], o0[1], o0[2], o0[3], o1[0], o1[1], o1[2], o1[3]};
                    *(h16x8*)(out + off + bj * HALF) = __builtin_convertvector(o, h16x8); } }
            asm volatile("" ::: "memory"); }
    }
};
template <class E, class = void> struct AccOf { typedef f32x4 type; };
template <class E> struct AccOf<E, decltype((void)sizeof(typename E::acc_t))> { typedef typename E::acc_t type; };
__device__ __forceinline__ f32x4 mma16(bf16x8 b, bf16x8 a, f32x4 c) { return __builtin_amdgcn_mfma_f32_16x16x32_bf16(b, a, c, 0, 0, 0); }
__device__ __forceinline__ i32x4 mma16(bf16x8 b, bf16x8 a, i32x4 c) { return __builtin_amdgcn_mfma_i32_16x16x64_i8(__builtin_bit_cast(i32x4, b), __builtin_bit_cast(i32x4, a), c, 0, 0, 0); }
template <class Epi, class Sched, bool ALIGN_EPI = false, bool SP2 = false>
__device__ __forceinline__ void gemm_phase(PG8_LAS unsigned char* lds, const Gemm g, const Sched& S, const Epi& E) {
    int tid_ = threadIdx.x; asm volatile("" : "+v"(tid_));
    const int tid = tid_, wid = __builtin_amdgcn_readfirstlane(tid >> 6), lane = tid & 63, wr = wid >> 2, wc = wid & 3, fr = lane & 15, fq = lane >> 4;
    const int K = g.K, nt = K / BK;
    unsigned voffA[2], voffB[2];
#pragma unroll
    for (int i = 0; i < 2; ++i) { int R, C; stage_rc(tid * 16 + i * 8192, R, C); const int Rb = Epi::PERM ? ((R & ~31) + perm32(R & 31)) : R;
        voffA[i] = (unsigned)(R * K + C) * 2u; voffB[i] = (unsigned)(Rb * K + C) * 2u; }
    const size_t kstep = (size_t)(BK * 2);
    const size_t hstep = (size_t)HALF * K * 2;
    const size_t tstep = 2 * hstep;
    const unsigned ldsw = (unsigned)wid * 1024u;
    const int aoff = lds_byte(wr * 64 + fr, fq * 8), boff = lds_byte(wc * 32 + fr, fq * 8);
#define PG8_SA(b, h) (((b) * 2 + (h)) * HTB)
#define PG8_SB(b, h) ((4 + (b) * 2 + (h)) * HTB)
#define PG8_STAGE(bufoff, gbase, voff) do { _Pragma("unroll") for (int _i = 0; _i < 2; ++_i) \
        __builtin_amdgcn_global_load_lds((const unsigned*)((const char*)(gbase) + (voff)[_i]), (PG8_LAS unsigned*)(lds + (bufoff) + ldsw + _i * 8192), 16, 0, 0); } while (0)
#define PG8_LDA(dst, b, h) do { _Pragma("unroll") for (int m = 0; m < 4; ++m) _Pragma("unroll") for (int k = 0; k < 2; ++k) dst[m][k] = *(const PG8_LAS bf16x8*)(lds + PG8_SA(b, h) + aoff + m * 2048 + k * 1024); } while (0)
#define PG8_LDB(dst, b, h) do { _Pragma("unroll") for (int n = 0; n < 2; ++n) _Pragma("unroll") for (int k = 0; k < 2; ++k) dst[n][k] = *(const PG8_LAS bf16x8*)(lds + PG8_SB(b, h) + boff + n * 2048 + k * 1024); } while (0)
#define PG8_MMA(ai, bj, At, Bt) do { __builtin_amdgcn_s_setprio(1); _Pragma("unroll") for (int m = 0; m < 4; ++m) _Pragma("unroll") for (int n = 0; n < 2; ++n) _Pragma("unroll") for (int k = 0; k < 2; ++k) \
        acc[ai][bj][m][n] = mma16(Bt[n][k], At[m][k], acc[ai][bj][m][n]); __builtin_amdgcn_s_setprio(0); } while (0)
#define PG8_WAIT_V(n) asm volatile("s_waitcnt vmcnt(" #n ")" ::: "memory")
#define PG8_WAIT_L(n) asm volatile("s_waitcnt lgkmcnt(" #n ")" ::: "memory")
#define PG8_BAR __builtin_amdgcn_s_barrier()
#define PG8_SCHED __builtin_amdgcn_sched_barrier(0)
    Unit cur, nxt; int ui = 0;
    if (!S.next(0, cur)) return;
    typedef typename AccOf<Epi>::type acc_t;
    acc_t acc[2][2][4][2];
#pragma unroll
    for (int a = 0; a < 2; ++a)
#pragma unroll
        for (int b = 0; b < 2; ++b)
#pragma unroll
            for (int m = 0; m < 4; ++m)
#pragma unroll
                for (int n = 0; n < 2; ++n) acc[a][b][m][n] = acc_t{};
    bf16x8 At[4][2], B0[2][2], B1[2][2];
    const char* cA = (const char*)g.A + (size_t)cur.pm * tstep; const char* cB = (const char*)g.Bt + (size_t)cur.pn * tstep;
    S.a_ready(cur);
    if constexpr (SP2) {
        PG8_STAGE(PG8_SB(0, 0), cB, voffB); PG8_STAGE(PG8_SB(0, 1), cB + hstep, voffB); PG8_STAGE(PG8_SA(0, 0), cA, voffA); PG8_STAGE(PG8_SA(0, 1), cA + hstep, voffA);
        if (wr == 1) PG8_BAR;
        PG8_WAIT_V(2); PG8_BAR;
        PG8_STAGE(PG8_SB(1, 0), cB + kstep, voffB); PG8_STAGE(PG8_SA(1, 0), cA + kstep, voffA); PG8_STAGE(PG8_SB(1, 1), cB + hstep + kstep, voffB);
        PG8_WAIT_V(6); PG8_BAR;
    } else {
        PG8_STAGE(PG8_SB(0, 0), cB, voffB); PG8_STAGE(PG8_SA(0, 0), cA, voffA); PG8_STAGE(PG8_SB(0, 1), cB + hstep, voffB); PG8_STAGE(PG8_SA(0, 1), cA + hstep, voffA);
        if (wr == 1) PG8_BAR;
        PG8_WAIT_V(4); PG8_BAR;
        PG8_STAGE(PG8_SB(1, 0), cB + kstep, voffB); PG8_STAGE(PG8_SA(1, 0), cA + kstep, voffA); PG8_STAGE(PG8_SB(1, 1), cB + hstep + kstep, voffB);
        PG8_WAIT_V(6); PG8_BAR;
    }
    for (;;) {
        const bool has_next = S.next(ui + 1, nxt);
        const char* nA = has_next ? (const char*)g.A + (size_t)nxt.pm * tstep : cA; const char* nB = has_next ? (const char*)g.Bt + (size_t)nxt.pn * tstep : cB;
        for (int t = 0; t < nt; t += 2) {
            const bool last = (t == nt - 2);
            const char* a1 = cA + (size_t)(t + 1) * kstep;
            const char* a2 = last ? nA : cA + (size_t)(t + 2) * kstep; const char* b2 = last ? nB : cB + (size_t)(t + 2) * kstep;
            const char* a3 = a2 + kstep; const char* b3 = b2 + kstep;
            if (last && has_next) S.a_ready(nxt);
            if constexpr (SP2) {
            PG8_LDB(B0, 0, 0); PG8_LDB(B1, 0, 1); PG8_SCHED; PG8_LDA(At, 0, 0); PG8_STAGE(PG8_SA(1, 1), a1 + hstep, voffA);
            PG8_WAIT_V(8); PG8_WAIT_L(0); PG8_BAR; PG8_MMA(0, 0, At, B0); PG8_MMA(0, 1, At, B1); PG8_BAR; PG8_SCHED;
            PG8_LDA(At, 0, 1); PG8_STAGE(PG8_SB(0, 0), b2, voffB); PG8_STAGE(PG8_SB(0, 1), b2 + hstep, voffB); PG8_STAGE(PG8_SA(0, 0), a2, voffA);
            PG8_WAIT_V(8); PG8_WAIT_L(0); PG8_BAR; PG8_MMA(1, 0, At, B0); PG8_MMA(1, 1, At, B1); PG8_BAR; PG8_SCHED;
            PG8_LDB(B0, 1, 0); PG8_LDB(B1, 1, 1); PG8_SCHED; PG8_LDA(At, 1, 0); PG8_STAGE(PG8_SA(0, 1), a2 + hstep, voffA);
            PG8_WAIT_V(8); PG8_WAIT_L(0); PG8_BAR; PG8_MMA(0, 0, At, B0); PG8_MMA(0, 1, At, B1); PG8_BAR; PG8_SCHED;
            PG8_LDA(At, 1, 1); PG8_STAGE(PG8_SB(1, 0), b3, voffB); PG8_STAGE(PG8_SB(1, 1), b3 + hstep, voffB); PG8_STAGE(PG8_SA(1, 0), a3, voffA);
            PG8_WAIT_V(8); PG8_WAIT_L(0); PG8_BAR; PG8_MMA(1, 0, At, B0); PG8_MMA(1, 1, At, B1); PG8_BAR; PG8_SCHED;
            } else {
            PG8_LDB(B0, 0, 0); PG8_SCHED; PG8_LDA(At, 0, 0); PG8_STAGE(PG8_SA(1, 1), a1 + hstep, voffA);
            PG8_WAIT_L(8); PG8_BAR; PG8_WAIT_L(0); PG8_MMA(0, 0, At, B0); PG8_BAR; PG8_SCHED;
            PG8_LDB(B1, 0, 1); PG8_STAGE(PG8_SB(0, 0), b2, voffB);
            PG8_BAR; PG8_WAIT_L(0); PG8_MMA(0, 1, At, B1); PG8_BAR;
            PG8_LDA(At, 0, 1); PG8_STAGE(PG8_SA(0, 0), a2, voffA);
            PG8_BAR; PG8_WAIT_L(0); PG8_MMA(1, 0, At, B0); PG8_BAR; PG8_SCHED;
            PG8_STAGE(PG8_SB(0, 1), b2 + hstep, voffB);
            PG8_WAIT_V(6); PG8_BAR; PG8_MMA(1, 1, At, B1); PG8_BAR;
            PG8_LDB(B0, 1, 0); PG8_SCHED; PG8_LDA(At, 1, 0); PG8_STAGE(PG8_SA(0, 1), a2 + hstep, voffA);
            PG8_WAIT_L(8); PG8_BAR; PG8_WAIT_L(0); PG8_MMA(0, 0, At, B0); PG8_BAR; PG8_SCHED;
            PG8_LDB(B1, 1, 1); PG8_STAGE(PG8_SB(1, 0), b3, voffB);
            PG8_BAR; PG8_WAIT_L(0); PG8_MMA(0, 1, At, B1); PG8_BAR;
            PG8_LDA(At, 1, 1); PG8_STAGE(PG8_SA(1, 0), a3, voffA);
            PG8_BAR; PG8_WAIT_L(0); PG8_MMA(1, 0, At, B0); PG8_BAR; PG8_SCHED;
            PG8_STAGE(PG8_SB(1, 1), b3 + hstep, voffB);
            PG8_WAIT_V(6); PG8_BAR; PG8_MMA(1, 1, At, B1); PG8_BAR;
            }
        }
        if constexpr (ALIGN_EPI) { if (wr == 0) PG8_BAR; }
        if constexpr (!Epi::AFTER_DRAIN) { E(acc, cur, wr, wc, fr, fq); S.done(cur); }
        if (!has_next) break;
#pragma unroll
        for (int a = 0; a < 2; ++a)
#pragma unroll
            for (int b = 0; b < 2; ++b)
#pragma unroll
                for (int m = 0; m < 4; ++m)
#pragma unroll
                    for (int n = 0; n < 2; ++n) acc[a][b][m][n] = acc_t{};
        cur = nxt; cA = nA; cB = nB; ++ui;
        if constexpr (ALIGN_EPI) { if (wr == 1) PG8_BAR; }
    }
    PG8_WAIT_V(0);
    if constexpr (!ALIGN_EPI) { if (wr == 0) PG8_BAR; }
    PG8_BAR;
    if constexpr (Epi::AFTER_DRAIN) { E.fused(acc, cur, wr, wc, fr, fq, lds, wid, lane); S.done(cur); }
#undef PG8_SA
#undef PG8_SB
#undef PG8_STAGE
#undef PG8_LDA
#undef PG8_LDB
#undef PG8_MMA
#undef PG8_WAIT_V
#undef PG8_WAIT_L
#undef PG8_BAR
#undef PG8_SCHED
}
}

#ifndef GEMM_SP2
#define GEMM_SP2 true
#endif
#ifndef GEMM_ALIGN
#define GEMM_ALIGN true
#endif
#ifndef DN_ORDER
#define DN_ORDER pg8::StaticOrderRev
#endif
constexpr int NWAVES = 8;
#ifndef MK_N_LAUNCHES
#define MK_N_LAUNCHES 1
#endif
constexpr int NPH = 2 + 12 * DEPTH;

constexpr size_t MiB = 1u << 20;
constexpr size_t WS_CTL = 0, CTL_ZERO_BYTES = 1 * MiB;
constexpr size_t WS_MOD = 1 * MiB;
constexpr size_t WS_FMOD = WS_MOD + (size_t)DEPTH * BATCH * NMOD * D * 4;
constexpr size_t WS_W = 2 * MiB, W_LAYER = 158 * MiB, W_FFN = 66 * MiB, W_DN = 44 * MiB, W_IN = 132 * MiB, W_OUT = 150 * MiB;
constexpr size_t WS_U = 640 * MiB;
constexpr size_t WS_HID = 768 * MiB;
constexpr size_t WS_OMIX = 1120 * MiB;
constexpr size_t WS_KVT = 1248 * MiB;
constexpr size_t WS_ST = 1504 * MiB;
constexpr size_t WS_DEC = 1632 * MiB;
constexpr size_t WS_H = 1634 * MiB;
constexpr size_t WS_TOK0 = 1762 * MiB;
constexpr size_t WS_SROW = 1763 * MiB;
constexpr size_t WS_SCOL = 1764 * MiB;
constexpr size_t WS_END = 1765 * MiB;
static_assert(WS_FMOD + (size_t)BATCH * 2 * D * 4 <= WS_W, "mod fits");
static_assert((size_t)NUP * D * 2 == 44 * MiB && (size_t)D * FF * 2 == 22 * MiB && (size_t)NIN * D * 2 == 18 * MiB && (size_t)D * D * 2 == 8 * MiB, "weight sizes");
static_assert(WS_W + DEPTH * W_LAYER <= WS_U && (size_t)M * D * 2 == 128 * MiB && (size_t)M * FF * 2 == 352 * MiB && (size_t)M * NIN * 2 <= 352 * MiB, "ws map");
constexpr int CW_TMO = 0, CW_CODE = 1;
constexpr int CW_BAR = 4096;

constexpr int RING_OFF = 0, RING_BYTES = 131072;
constexpr int LDSCTL_OFF = RING_BYTES, MISC_OFF = LDSCTL_OFF + 320;
constexpr int LDS_BYTES = 147456;
static_assert(MISC_OFF + 128 <= LDS_BYTES, "LDS map");

#define GAS __attribute__((address_space(1)))
#define LAS __attribute__((address_space(3)))
typedef unsigned short bf16;
typedef unsigned v4u __attribute__((ext_vector_type(4)));
typedef unsigned v2u __attribute__((ext_vector_type(2)));
typedef float f32x2 __attribute__((ext_vector_type(2)));
typedef float f32x4 __attribute__((ext_vector_type(4)));
typedef float f32x16 __attribute__((ext_vector_type(16)));
typedef short bf16x8 __attribute__((ext_vector_type(8)));
typedef short s16x4 __attribute__((ext_vector_type(4)));
typedef GAS unsigned gu32;
#define RLX_AGENT __ATOMIC_RELAXED, __HIP_MEMORY_SCOPE_AGENT
#define LDS_WAIT() asm volatile("s_waitcnt lgkmcnt(0)" ::: "memory")
#define VM_WAIT() asm volatile("s_waitcnt vmcnt(0)" ::: "memory")
#define MFMA32(a, b, c) __builtin_amdgcn_mfma_f32_32x32x16_bf16((a), (b), (c), 0, 0, 0)
__device__ __forceinline__ unsigned f2bf(float f) { unsigned u = __builtin_bit_cast(unsigned, f); return (u + 0x7fffu + ((u >> 16) & 1u)) >> 16; }
__device__ __forceinline__ unsigned pk2(float lo, float hi) { return pg8::cvtpk(lo, hi); }
__device__ __forceinline__ float bf2f(unsigned b) { return __builtin_bit_cast(float, b << 16); }
__device__ __forceinline__ int crow(int r, int hi) { return (r & 3) + 8 * (r >> 2) + 4 * hi; }
__device__ __forceinline__ bf16x8 pack8(const f32x16& x, int s, float sc) {
    v4u p; p.x = pk2(x[8 * s + 0] * sc, x[8 * s + 1] * sc); p.y = pk2(x[8 * s + 2] * sc, x[8 * s + 3] * sc); p.z = pk2(x[8 * s + 4] * sc, x[8 * s + 5] * sc); p.w = pk2(x[8 * s + 6] * sc, x[8 * s + 7] * sc);
    return __builtin_bit_cast(bf16x8, p);
}
__device__ __forceinline__ float shx(float v, int o, int lane) { return __builtin_bit_cast(float, __builtin_amdgcn_ds_bpermute((lane ^ o) << 2, __builtin_bit_cast(int, v))); }
__device__ __forceinline__ float wave_max(float v, int lane) {
#pragma unroll
    for (int o = 1; o < 64; o <<= 1) v = fmaxf(v, shx(v, o, lane));
    return v;
}
__device__ __forceinline__ unsigned q8x4(f32x4 y, float inv) {
    const int a = (int)__builtin_rintf(y.x * inv), b = (int)__builtin_rintf(y.y * inv), c = (int)__builtin_rintf(y.z * inv), d = (int)__builtin_rintf(y.w * inv);
    return (unsigned)(a & 0xff) | ((unsigned)(b & 0xff) << 8) | ((unsigned)(c & 0xff) << 16) | ((unsigned)(d & 0xff) << 24);
}
__device__ __forceinline__ float wave_sum(float v, int lane) {
#pragma unroll
    for (int o = 1; o < 64; o <<= 1) v += shx(v, o, lane);
    return v;
}
#define XB_TMO      128
#define XB_XCNT(j)  (256  + 64 * (j))
#define XB_XSUB(j)  (1280 + 64 * (j))
#define XB_XGEN(j)  (2304 + 64 * (j))
#define XB_TOP      3328
#define XB_TOPGEN   3392
#define XCD_BAR_WORDS 3456
#define XB_SPIN_CAP (1u << 18)

__device__ __forceinline__ unsigned xb_ld(unsigned* p)              { return __hip_atomic_load(p, __ATOMIC_RELAXED, __HIP_MEMORY_SCOPE_AGENT); }
__device__ __forceinline__ unsigned xb_add(unsigned* p, unsigned v) { return __hip_atomic_fetch_add(p, v, __ATOMIC_RELAXED, __HIP_MEMORY_SCOPE_AGENT); }
__device__ __forceinline__ unsigned xb_xcc_id() { return (unsigned)__builtin_amdgcn_s_getreg((3 << 11) | 20) & 0xFu; }
#define XB_SPIN(cond, bar) do { unsigned _sp = 0; while (cond) { __builtin_amdgcn_s_sleep(1); \
    if ((++_sp & 255u) == 0u) { if (xb_ld(&(bar)[XB_TMO])) break; if (_sp > XB_SPIN_CAP) { atomicAdd(&(bar)[XB_TMO], 1u); break; } } } } while (0)

struct XcdBarrier {
    unsigned* bar; unsigned x;
    volatile LAS unsigned* st;
};

__device__ __forceinline__ XcdBarrier xcd_barrier_post(unsigned* bar, volatile LAS unsigned* st) {
    XcdBarrier b; b.bar = bar; b.x = xb_xcc_id(); b.st = st;
    if (threadIdx.x == 0) (void)xb_add(&bar[XB_XCNT(b.x)], 1u);
    return b;
}
__device__ __forceinline__ void xcd_barrier_complete(unsigned* bar, unsigned x, unsigned& nloc, unsigned& nx) {
    const unsigned G = gridDim.x * gridDim.y * gridDim.z;
    unsigned sum, cnt, mine, sp = 0u;
    for (;;) {
        sum = 0u; cnt = 0u; mine = 0u;
#pragma unroll
        for (unsigned j = 0; j < 16; ++j) { const unsigned c = xb_ld(&bar[XB_XCNT(j)]); sum += c; cnt += (c > 0u) ? 1u : 0u; mine = (j == x) ? c : mine; }
        if (sum == G) break;
        __builtin_amdgcn_s_sleep(1);
        if ((++sp & 255u) == 0u) { if (xb_ld(&bar[XB_TMO])) break; if (sp > XB_SPIN_CAP) { atomicAdd(&bar[XB_TMO], 1u); break; } }
    }
    nloc = mine > 0u ? mine : 1u; nx = cnt > 0u ? cnt : 1u;
}

__device__ __forceinline__ void xcd_barrier(const XcdBarrier& b) {
    asm volatile("s_waitcnt vmcnt(0)" ::: "memory");
    __syncthreads();
    if (threadIdx.x == 0) {
        unsigned* bar = b.bar;
#ifdef PROBE_WAIT
        const unsigned long long t0_ = wall_clock64();
        const unsigned rnd_ = b.st[6]; b.st[6] = rnd_ + 1u;
        atomicMax(&bar[4204 + rnd_], (unsigned)t0_);
#endif
        __builtin_amdgcn_s_waitcnt(0);
        unsigned nloc = b.st[0], nx = b.st[1];
        if (nloc == 0u) { xcd_barrier_complete(bar, b.x, nloc, nx); b.st[0] = nloc; b.st[1] = nx; }
#ifdef EARLY_WB
        __builtin_amdgcn_fence(__ATOMIC_RELEASE, "agent");
        asm volatile("s_waitcnt vmcnt(0)" ::: "memory");
#endif
        const unsigned old = xb_add(&bar[XB_XSUB(b.x)], 1u);
        const unsigned gen = old / nloc;
        if (old + 1u == (gen + 1u) * nloc) {
#ifdef PROBE_WAIT
            const unsigned long long t1_ = wall_clock64();
#endif
            __builtin_amdgcn_fence(__ATOMIC_RELEASE, "agent");
            asm volatile("s_waitcnt vmcnt(0)" ::: "memory");
#ifdef PROBE_WAIT
            b.st[5] += (unsigned)(wall_clock64() - t1_);
#endif
            const unsigned og = xb_add(&bar[XB_TOP], 1u);
            const unsigned tg = og / nx;
            if (og + 1u == (tg + 1u) * nx) xb_add(&bar[XB_TOPGEN], 1u);
            else XB_SPIN(xb_ld(&bar[XB_TOPGEN]) == tg, bar);
            __builtin_amdgcn_fence(__ATOMIC_ACQUIRE, "agent");
#ifndef BAR_FLAT
            xb_add(&bar[XB_XGEN(b.x)], 1u);
#endif
            asm volatile("s_waitcnt vmcnt(0)" ::: "memory");
        } else {
#ifdef BAR_FLAT
            XB_SPIN(xb_ld(&bar[XB_TOPGEN]) == gen, bar);
#else
            XB_SPIN(xb_ld(&bar[XB_XGEN(b.x)]) == gen, bar);
#endif
            __builtin_amdgcn_fence(__ATOMIC_ACQUIRE, "agent");
            asm volatile("s_waitcnt vmcnt(0)" ::: "memory");
        }
#ifdef PROBE_WAIT
        { const unsigned long long t2_ = wall_clock64(); { const int q_ = rnd_ >= 2u ? (int)((rnd_ - 2u) % 12u) : 12; if ((PROBE_QMASK >> q_) & 1) b.st[4] += (unsigned)(t2_ - t0_); } if (blockIdx.x == 0) b.st[7] += (unsigned)t2_ - xb_ld(&bar[4204 + rnd_]); }
#endif
    }
    __syncthreads();
}

struct Args { const float* in[22]; float* out; unsigned char* ws; int ph_lo, ph_hi, li, pad; };
struct Ctx {
    LAS unsigned char* lds;
    int tid, lane, wave, G, gw, NGW;
};
enum { I_X = 0, I_C, I_ADAW, I_ADAB, I_NFFN1, I_F1W1, I_F1W3, I_F1W2, I_NMIX, I_WIN, I_GW2, I_GB, I_SINK, I_GNORM, I_WOUT, I_NFFN2, I_F2W1, I_F2W3, I_F2W2, I_FADAW, I_FADAB, I_FNORM };

__device__ __forceinline__ void p0_mod(const Ctx& C, const Args& a) {
    LAS float* cact = (LAS float*)C.lds;
    LAS float* red = (LAS float*)(C.lds + 16384);
    for (int i = C.tid; i < BATCH * D; i += NWAVES * 64) { const float c = a.in[I_C][i]; cact[i] = c / (1.0f + expf(-c)); }
    __syncthreads();
    float* modp = (float*)(a.ws + WS_MOD); float* fmodp = (float*)(a.ws + WS_FMOD);
    constexpr int IT_L = NMOD * D / 256, NITEM = DEPTH * IT_L + 2 * D / 256;
    for (int it = blockIdx.x; it < NITEM; it += C.G) {
        const float* W; const float* bias; float* o0; int N, c0;
        if (it < DEPTH * IT_L) { const int l = it / IT_L; c0 = (it % IT_L) * 256; N = NMOD * D; W = a.in[I_ADAW] + (size_t)l * D * N; bias = a.in[I_ADAB] + (size_t)l * N; o0 = modp + (size_t)l * BATCH * N; }
        else { c0 = (it - DEPTH * IT_L) * 256; N = 2 * D; W = a.in[I_FADAW]; bias = a.in[I_FADAB]; o0 = fmodp; }
        f32x4 a0 = {0.f, 0.f, 0.f, 0.f}, a1 = {0.f, 0.f, 0.f, 0.f};
        const int kb = 256 * C.wave;
        const float* wp = W + (size_t)kb * N + c0 + 4 * C.lane;
#pragma unroll 8
        for (int k = 0; k < 256; ++k) { const f32x4 w = *(const f32x4*)(wp + (size_t)k * N); const float x0 = cact[kb + k], x1 = cact[D + kb + k]; a0 += w * x0; a1 += w * x1; }
#pragma unroll
        for (int j = 0; j < 4; ++j) { red[(C.wave * 2 + 0) * 256 + 4 * C.lane + j] = a0[j]; red[(C.wave * 2 + 1) * 256 + 4 * C.lane + j] = a1[j]; }
        __syncthreads();
        { const int b = C.tid >> 8, col = C.tid & 255; float s = 0.f;
#pragma unroll
          for (int w = 0; w < 8; ++w) s += red[(w * 2 + b) * 256 + col];
          o0[(size_t)b * N + c0 + col] = s + bias[c0 + col]; }
        __syncthreads();
    }
}
__device__ __forceinline__ void p0_transpose_item(const float* W, int K, int N, int nvalid, bf16* dst, LAS float* scr, int k0, int n0, int lane) {
    const int col = n0 + (lane & 31); const bool ok = col < nvalid;
    const float* src = W + (size_t)(k0 + (lane >> 5)) * N + (ok ? col : 0);
    float t[32];
#pragma unroll
    for (int i = 0; i < 32; ++i) t[i] = src[(size_t)(2 * i) * N];
#pragma unroll
    for (int i = 0; i < 32; ++i) scr[(2 * i + (lane >> 5)) * 33 + (lane & 31)] = ok ? t[i] : 0.f;
    LDS_WAIT(); asm volatile("" ::: "memory");
    const int c = lane & 7;
#pragma unroll
    for (int j = 0; j < 4; ++j) { const int n = (lane >> 3) + 8 * j; const LAS float* s = scr + (8 * c) * 33 + n;
        v4u o; o.x = pk2(s[0 * 33], s[1 * 33]); o.y = pk2(s[2 * 33], s[3 * 33]); o.z = pk2(s[4 * 33], s[5 * 33]); o.w = pk2(s[6 * 33], s[7 * 33]);
        *(GAS v4u*)(dst + (size_t)n * K + k0 + 8 * c) = o; }
    LDS_WAIT(); asm volatile("" ::: "memory");
}
__device__ __forceinline__ void p0_transpose_item_i8(const float* W, int N, int K8, signed char* dst8, const LAS float* cmax, float* sc, LAS float* scr, int k0, int n0, int lane) {
    const float* src = W + (size_t)(k0 + (lane >> 5)) * N + n0 + (lane & 31);
    float t[32];
#pragma unroll
    for (int i = 0; i < 32; ++i) t[i] = src[(size_t)(2 * i) * N];
#pragma unroll
    for (int i = 0; i < 32; ++i) scr[(2 * i + (lane >> 5)) * 33 + (lane & 31)] = t[i];
    LDS_WAIT(); asm volatile("" ::: "memory");
    const int c = lane & 7;
#pragma unroll
    for (int j = 0; j < 4; ++j) { const int n = (lane >> 3) + 8 * j; const LAS float* p = scr + (8 * c) * 33 + n;
        const float sv = cmax[n] * (1.0f / 127.0f), inv = sv > 0.f ? 1.0f / sv : 0.f;
        if (k0 == 0 && c == 0) sc[n] = sv;
        v2u o; o.x = q8x4((f32x4){p[0 * 33], p[1 * 33], p[2 * 33], p[3 * 33]}, inv); o.y = q8x4((f32x4){p[4 * 33], p[5 * 33], p[6 * 33], p[7 * 33]}, inv);
        *(GAS v2u*)(dst8 + (size_t)n * K8 + k0 + 8 * c) = o; }
    LDS_WAIT(); asm volatile("" ::: "memory");
}
constexpr int P0_I_UP = (D / 64) * (FF / 32), P0_I_DN = (FF / 64) * (D / 32), P0_I_IN = (D / 64) * (NIN / 32), P0_I_OUT = (D / 64) * (D / 32);
constexpr int P0_NCV0 = DEPTH * (2 * P0_I_DN + P0_I_IN + P0_I_OUT);
constexpr int P0_NUPT = DEPTH * 4 * (FF / 32);
__device__ __forceinline__ void p0_up_task(const Ctx& C, const Args& a, LAS float* scr, LAS float* cm, int it) {
    constexpr int NB = FF / 32;
    const int l = it / (4 * NB); int r = it % (4 * NB); const int f = r / (2 * NB); r %= 2 * NB; const int which = r / NB, nb = r % NB;
    const float* W = a.in[f ? (which ? I_F2W3 : I_F2W1) : (which ? I_F1W3 : I_F1W1)] + (size_t)l * D * FF;
    { const float* src = W + (size_t)(256 * C.wave + (C.lane >> 5)) * FF + 32 * nb + (C.lane & 31);
      float mx = 0.f;
#pragma unroll 16
      for (int i = 0; i < 128; ++i) mx = fmaxf(mx, fabsf(src[(size_t)(2 * i) * FF]));
      mx = fmaxf(mx, shx(mx, 32, C.lane));
      if (C.lane < 32) cm[C.wave * 32 + C.lane] = mx; }
    __syncthreads();
    if (C.tid < 32) { float m = cm[C.tid];
#pragma unroll
        for (int w = 1; w < NWAVES; ++w) m = fmaxf(m, cm[w * 32 + C.tid]);
        cm[NWAVES * 32 + C.tid] = m; }
    __syncthreads();
    unsigned char* wl = a.ws + WS_W + (size_t)l * W_LAYER;
    const int jr = (nb >> 2) * 256 + (nb & 3) * 32 + which * 128;
    const size_t so = (size_t)(l * 2 + f) * NUP + jr;
#pragma unroll 1
    for (int q = 0; q < 4; ++q)
        p0_transpose_item_i8(W, FF, D, (signed char*)(wl + f * W_FFN) + (size_t)jr * D, cm + NWAVES * 32, (float*)(a.ws + WS_SCOL) + so, scr, 64 * (4 * C.wave + q), 32 * nb, C.lane);
    __syncthreads();
}
__device__ __forceinline__ void p0_conv0_item(const Args& a, LAS float* scr, int it, int lane) {
    constexpr int PER_L = 2 * P0_I_DN + P0_I_IN + P0_I_OUT;
    const int l = it / PER_L; int r = it % PER_L;
    unsigned char* wl = a.ws + WS_W + (size_t)l * W_LAYER;
    if (r < 2 * P0_I_DN) { const int f = r / P0_I_DN; r %= P0_I_DN; const int kb = r / (D / 32), nb = r % (D / 32);
        const float* W = a.in[f ? I_F2W2 : I_F1W2] + (size_t)l * FF * D;
        p0_transpose_item(W, FF, D, D, (bf16*)(wl + f * W_FFN + W_DN) + (size_t)(32 * nb) * FF, scr, 64 * kb, 32 * nb, lane); }
    else { r -= 2 * P0_I_DN;
        if (r < P0_I_IN) { const int kb = r / (NIN / 32), nb = r % (NIN / 32);
            p0_transpose_item(a.in[I_WIN] + (size_t)l * D * NINR, D, NINR, NINR, (bf16*)(wl + W_IN) + (size_t)(32 * nb) * D, scr, 64 * kb, 32 * nb, lane); }
        else { r -= P0_I_IN; const int kb = r / (D / 32), nb = r % (D / 32);
            p0_transpose_item(a.in[I_WOUT] + (size_t)l * D * D, D, D, D, (bf16*)(wl + W_OUT) + (size_t)(32 * nb) * D, scr, 64 * kb, 32 * nb, lane); } }
}
constexpr int P0_MOD_ITEMS = DEPTH * (NMOD * D / 256) + 2 * D / 256;
#ifndef P0_CV_LO
#define P0_CV_LO 159
#define P0_CV_HI 308
#endif
__device__ __forceinline__ unsigned wg_draw(volatile LAS unsigned* q, int lane) {
    unsigned v = 0u; if (lane == 0) v = __hip_atomic_fetch_add((LAS unsigned*)q, 1u, __ATOMIC_RELAXED, __HIP_MEMORY_SCOPE_WORKGROUP);
    return (unsigned)__builtin_amdgcn_readfirstlane((int)v);
}
__device__ __forceinline__ void p0_phase_a(const Ctx& C, const Args& a, volatile LAS unsigned* q) {
    LAS float* scr = (LAS float*)(C.lds + 32768 + C.wave * 8704);
    LAS float* cm = (LAS float*)(C.lds + 32768 + NWAVES * 8704);
    const int w = blockIdx.x, G = C.G;
    int c0, cn;
    if (G == 256) { const int extra = P0_MOD_ITEMS - 256; c0 = w < extra ? P0_CV_LO * w : P0_CV_LO * extra + P0_CV_HI * (w - extra); cn = w < extra ? P0_CV_LO : P0_CV_HI; }
    else { c0 = (int)((long long)P0_NCV0 * w / G); cn = (int)((long long)P0_NCV0 * (w + 1) / G) - c0; }
    if (c0 > P0_NCV0) c0 = P0_NCV0;
    if (c0 + cn > P0_NCV0) cn = P0_NCV0 - c0;
    if (G == 256 && w == G - 1) cn = P0_NCV0 - c0;
    const int m0 = (int)((long long)P0_NUPT * w / G), m1 = (int)((long long)P0_NUPT * (w + 1) / G);
#pragma unroll 1
    for (int t = m0; t < m1; ++t) p0_up_task(C, a, scr, cm, t);
    for (;;) { const unsigned i = wg_draw(q, C.lane); if (i >= (unsigned)cn) break; p0_conv0_item(a, scr, c0 + (int)i, C.lane); }
}

template <bool FINAL>
__device__ __forceinline__ void norm_phase(const Ctx& C, const float* src, const float* w, const float* shv, const float* scv, int bstride, bf16* u, float* outf) {
    int cur_b = -1; f32x4 A[8], B[8];
#pragma unroll
    for (int j = 0; j < 8; ++j) { A[j] = (f32x4){0.f, 0.f, 0.f, 0.f}; B[j] = A[j]; }
    for (int m = C.gw; m < M; m += C.NGW) {
        const int b = m >= SEQ ? 1 : 0;
        if (b != cur_b) { cur_b = b;
#pragma unroll
            for (int j = 0; j < 8; ++j) { const int col = 4 * (C.lane + 64 * j); const f32x4 wv = *(const f32x4*)(w + col), sc = *(const f32x4*)(scv + (size_t)b * bstride + col); A[j] = wv * (sc + 1.0f); B[j] = *(const f32x4*)(shv + (size_t)b * bstride + col); } }
        const f32x4* xr = (const f32x4*)(src + (size_t)m * D) + C.lane;
        f32x4 v[8]; float s = 0.f;
#pragma unroll
        for (int j = 0; j < 8; ++j) v[j] = xr[64 * j];
#pragma unroll
        for (int j = 0; j < 8; ++j) s += (v[j].x * v[j].x + v[j].y * v[j].y) + (v[j].z * v[j].z + v[j].w * v[j].w);
        const float r = 1.0f / sqrtf(wave_sum(s, C.lane) * (1.0f / D) + EPS);
#pragma unroll
        for (int j = 0; j < 8; ++j) { const f32x4 y = v[j] * r * A[j] + B[j];
            if (FINAL) ((f32x4*)(outf + (size_t)m * D))[C.lane + 64 * j] = y;
            else { v2u o; o.x = pk2(y.x, y.y); o.y = pk2(y.z, y.w); ((v2u*)(u + (size_t)m * D))[C.lane + 64 * j] = o; } }
    }
}

typedef _Float16 h16x8n __attribute__((ext_vector_type(8)));
typedef float f32x8n __attribute__((ext_vector_type(8)));
template <bool FINAL>
__device__ __forceinline__ void norm_phase_h(const Ctx& C, const _Float16* src, const float* w, const float* shv, const float* scv, int bstride, bf16* u, float* outf) {
    int cur_b = -1; f32x4 A[8], B[8];
#pragma unroll
    for (int j = 0; j < 8; ++j) { A[j] = (f32x4){0.f, 0.f, 0.f, 0.f}; B[j] = A[j]; }
    for (int m = C.gw; m < M; m += C.NGW) {
        const int b = m >= SEQ ? 1 : 0;
        if (b != cur_b) { cur_b = b;
#pragma unroll
            for (int j = 0; j < 8; ++j) { const int col = 8 * (C.lane + 64 * (j >> 1)) + 4 * (j & 1); const f32x4 wv = *(const f32x4*)(w + col), sc = *(const f32x4*)(scv + (size_t)b * bstride + col); A[j] = wv * (sc + 1.0f); B[j] = *(const f32x4*)(shv + (size_t)b * bstride + col); } }
        const h16x8n* xr = (const h16x8n*)(src + (size_t)m * D) + C.lane;
        h16x8n q[4]; f32x4 v[8]; float s = 0.f;
#pragma unroll
        for (int j = 0; j < 4; ++j) q[j] = xr[64 * j];
#pragma unroll
        for (int j = 0; j < 4; ++j) { const f32x8n f = __builtin_convertvector(q[j], f32x8n); v[2 * j] = (f32x4){f[0], f[1], f[2], f[3]}; v[2 * j + 1] = (f32x4){f[4], f[5], f[6], f[7]}; }
#pragma unroll
        for (int j = 0; j < 8; ++j) s += (v[j].x * v[j].x + v[j].y * v[j].y) + (v[j].z * v[j].z + v[j].w * v[j].w);
        const float r = 1.0f / sqrtf(wave_sum(s, C.lane) * (1.0f / D) + EPS);
#pragma unroll
        for (int j = 0; j < 4; ++j) { const f32x4 y0 = v[2 * j] * r * A[2 * j] + B[2 * j], y1 = v[2 * j + 1] * r * A[2 * j + 1] + B[2 * j + 1];
            if (FINAL) { f32x4* o = (f32x4*)(outf + (size_t)m * D + 8 * (C.lane + 64 * j)); o[0] = y0; o[1] = y1; }
            else { v4u o; o.x = pk2(y0.x, y0.y); o.y = pk2(y0.z, y0.w); o.z = pk2(y1.x, y1.y); o.w = pk2(y1.z, y1.w); ((v4u*)(u + (size_t)m * D))[C.lane + 64 * j] = o; } }
    }
}

template <bool SRC_F32>
__device__ __forceinline__ void norm_q8(const Ctx& C, const void* src, const float* w, const float* shv, const float* scv, int bstride, signed char* u8, float* srow) {
    int cur_b = -1; f32x4 A[8], B[8];
#pragma unroll
    for (int j = 0; j < 8; ++j) { A[j] = (f32x4){0.f, 0.f, 0.f, 0.f}; B[j] = A[j]; }
    for (int m = C.gw; m < M; m += C.NGW) {
        const int b = m >= SEQ ? 1 : 0;
        if (b != cur_b) { cur_b = b;
#pragma unroll
            for (int j = 0; j < 8; ++j) { const int col = 8 * (C.lane + 64 * (j >> 1)) + 4 * (j & 1); const f32x4 wv = *(const f32x4*)(w + col), sc = *(const f32x4*)(scv + (size_t)b * bstride + col); A[j] = wv * (sc + 1.0f); B[j] = *(const f32x4*)(shv + (size_t)b * bstride + col); } }
        f32x4 v[8]; float s = 0.f;
        if (SRC_F32) { const f32x4* xr = (const f32x4*)((const float*)src + (size_t)m * D);
#pragma unroll
            for (int j = 0; j < 8; ++j) v[j] = xr[2 * (C.lane + 64 * (j >> 1)) + (j & 1)]; }
        else { const h16x8n* xr = (const h16x8n*)((const _Float16*)src + (size_t)m * D) + C.lane;
#pragma unroll
            for (int j = 0; j < 4; ++j) { const f32x8n f = __builtin_convertvector(xr[64 * j], f32x8n); v[2 * j] = (f32x4){f[0], f[1], f[2], f[3]}; v[2 * j + 1] = (f32x4){f[4], f[5], f[6], f[7]}; } }
#pragma unroll
        for (int j = 0; j < 8; ++j) s += (v[j].x * v[j].x + v[j].y * v[j].y) + (v[j].z * v[j].z + v[j].w * v[j].w);
        const float r = 1.0f / sqrtf(wave_sum(s, C.lane) * (1.0f / D) + EPS);
        float am = 0.f;
#pragma unroll
        for (int j = 0; j < 8; ++j) { v[j] = v[j] * r * A[j] + B[j]; am = fmaxf(am, fmaxf(fmaxf(fabsf(v[j].x), fabsf(v[j].y)), fmaxf(fabsf(v[j].z), fabsf(v[j].w)))); }
        am = wave_max(am, C.lane);
        const float inv = am > 0.f ? 127.0f / am : 0.f;
        if (C.lane == 0) srow[m] = am * (1.0f / 127.0f);
#pragma unroll
        for (int j = 0; j < 4; ++j) { v2u o; o.x = q8x4(v[2 * j], inv); o.y = q8x4(v[2 * j + 1], inv); ((v2u*)(u8 + (size_t)m * D))[C.lane + 64 * j] = o; }
    }
}

constexpr int AT_KROW = 144, AT_VROW = 520, AT_K_OFF = 0, AT_V_OFF = 256 * AT_KROW;
__device__ __forceinline__ void attn_unit(const Ctx& C, const bf16* __restrict__ P, bf16* __restrict__ O, const float* sinks, int unit) {
    const int kv = unit & 1, n = (unit >> 1) & (NBLK - 1), b = unit >> 8;
    const int tb = b * SEQ + n * BLK;
    LAS unsigned char* KL = C.lds + AT_K_OFF; LAS unsigned char* VL = C.lds + AT_V_OFF;
#pragma unroll
    for (int j = 0; j < 4; ++j) { const int idx = C.tid + 512 * j, key = idx >> 3, part = idx & 7;
        v4u kq = {0u, 0u, 0u, 0u}, vq = {0u, 0u, 0u, 0u};
        if (n > 0 || key >= BLK) { const bf16* row = P + (size_t)(tb + key - BLK) * NIN; kq = *(const v4u*)(row + PC_KA + kv * HD + 8 * part); vq = *(const v4u*)(row + PC_VA + kv * HD + 8 * part); }
        *(LAS v4u*)(KL + key * AT_KROW + part * 16) = kq;
        const unsigned vv[4] = {vq.x, vq.y, vq.z, vq.w};
#pragma unroll
        for (int q = 0; q < 4; ++q) { *(LAS unsigned short*)(VL + (8 * part + 2 * q) * AT_VROW + key * 2) = (unsigned short)(vv[q] & 0xffffu); *(LAS unsigned short*)(VL + (8 * part + 2 * q + 1) * AT_VROW + key * 2) = (unsigned short)(vv[q] >> 16); } }
    __syncthreads();
    const int r = C.lane & 31, h = C.lane >> 5, head = kv * GQA + C.wave;
    const float slope = exp2f(-0.5f * (float)(head + 1)), sink = sinks[head];
#pragma unroll 1
    for (int qb = 0; qb < 4; ++qb) {
        bf16x8 qf[4];
        { const bf16* qrow = P + (size_t)(tb + 32 * qb + r) * NIN + PC_QA + head * HD + 8 * h;
#pragma unroll
          for (int s = 0; s < 4; ++s) qf[s] = *(const bf16x8*)(qrow + 16 * s); }
        f32x16 sa[5];
#pragma unroll
        for (int k5 = 0; k5 < 5; ++k5) {
#pragma unroll
            for (int i = 0; i < 16; ++i) sa[k5][i] = 0.f;
#pragma unroll
            for (int s = 0; s < 4; ++s) { const bf16x8 kf = *(const LAS bf16x8*)(KL + (32 * (qb + k5) + r) * AT_KROW + (16 * s + 8 * h) * 2); sa[k5] = MFMA32(kf, qf[s], sa[k5]); } }
        const int qi = 32 * qb + r; float mx = -INFINITY;
#pragma unroll
        for (int k5 = 0; k5 < 5; ++k5)
#pragma unroll
            for (int i = 0; i < 16; ++i) { const int kj = 32 * (qb + k5) + crow(i, h), dist = qi + BLK - kj; const bool valid = (dist >= 0) && (dist < WIN) && (n > 0 || kj >= BLK);
                const float v = valid ? sa[k5][i] * 0.125f - slope * (float)dist : -INFINITY; sa[k5][i] = v; mx = fmaxf(mx, v); }
        mx = fmaxf(mx, shx(mx, 32, C.lane)); mx = fmaxf(mx, sink);
        float sum = 0.f;
#pragma unroll
        for (int k5 = 0; k5 < 5; ++k5)
#pragma unroll
            for (int i = 0; i < 16; ++i) { const float p = __expf(sa[k5][i] - mx); sa[k5][i] = p; sum += p; }
        sum += shx(sum, 32, C.lane); sum += __expf(sink - mx);
        const float inv = 1.0f / sum;
        f32x16 o[2];
#pragma unroll
        for (int i = 0; i < 16; ++i) { o[0][i] = 0.f; o[1][i] = 0.f; }
#pragma unroll
        for (int k5 = 0; k5 < 5; ++k5)
#pragma unroll
            for (int st = 0; st < 2; ++st) { const bf16x8 pf = pack8(sa[k5], st, inv);
#pragma unroll
                for (int db = 0; db < 2; ++db) { const LAS unsigned char* vp = VL + (32 * db + r) * AT_VROW + (32 * (qb + k5) + 16 * st + 4 * h) * 2;
                    const s16x4 lo = *(const LAS s16x4*)vp, hi = *(const LAS s16x4*)(vp + 16);
                    const bf16x8 vf = __builtin_shufflevector(lo, hi, 0, 1, 2, 3, 4, 5, 6, 7);
                    o[db] = MFMA32(pf, vf, o[db]); } }
#pragma unroll
        for (int db = 0; db < 2; ++db)
#pragma unroll
            for (int i = 0; i < 16; ++i) O[(size_t)(tb + 32 * qb + crow(i, h)) * D + head * HD + 32 * db + r] = (bf16)f2bf(o[db][i]);
    }
    __syncthreads();
}

constexpr int GL_QT = 0, GL_KT = 17408, GL_KET = 34816, GL_VT = 53248, GL_GLR = 90112, GL_TOT = 94208, GL_OT = 0, GL_QROW = 272, GL_TROW = 144, GL_OROW = 260;
__device__ __forceinline__ void gla_decay(const Ctx& C, const Args& a, const bf16* __restrict__ P, int l, int h, int t0, float (&bl)[16], float& blast) {
    LAS float* GLR = (LAS float*)(C.lds + GL_GLR); LAS float* TOT = (LAS float*)(C.lds + GL_TOT);
    const int d = C.tid & 127, cg = C.tid >> 7;
    { const int idx = 2 * C.tid, c = idx >> 4, rr = idx & 15; const unsigned w = *(const unsigned*)(P + (size_t)(t0 + c) * NIN + PC_GL + rr); GLR[idx] = bf2f(w & 0xffffu); GLR[idx + 1] = bf2f(w >> 16); }
    float w2[16];
    const float* gw2 = a.in[I_GW2] + (size_t)l * GRANK * (GH * GDK) + h * GDK + d;
#pragma unroll
    for (int rr = 0; rr < 16; ++rr) w2[rr] = gw2[rr * (GH * GDK)];
    const float gb = a.in[I_GB][l * (GH * GDK) + h * GDK + d];
    __syncthreads();
    float run = 0.f;
#pragma unroll
    for (int i = 0; i < 16; ++i) { const LAS float* g = GLR + (16 * cg + i) * 16; float z = gb;
#pragma unroll
        for (int rr = 0; rr < 16; ++rr) z += g[rr] * w2[rr];
        const float ls = fminf(z, 0.f) - log1pf(expf(-fabsf(z)));
        run += ls * (1.0f / 16.0f); bl[i] = run; }
    TOT[cg * 128 + d] = run;
    __syncthreads();
    float off = 0.f, tot = 0.f;
#pragma unroll
    for (int g = 0; g < 4; ++g) { const float t = TOT[g * 128 + d]; tot += t; if (g < cg) off += t; }
#pragma unroll
    for (int i = 0; i < 16; ++i) bl[i] += off;
    blast = tot;
}
__device__ __forceinline__ void gla_stage_vt(const Ctx& C, const bf16* __restrict__ P, int h, int t0) {
    LAS unsigned char* VT = C.lds + GL_VT;
#pragma unroll
    for (int j = 0; j < 4; ++j) { const int idx = C.tid + 512 * j, c = idx >> 5, e8 = idx & 31;
        const v4u vq = *(const v4u*)(P + (size_t)(t0 + c) * NIN + PC_VG + h * GDV + 8 * e8);
        const unsigned vv[4] = {vq.x, vq.y, vq.z, vq.w};
#pragma unroll
        for (int q = 0; q < 4; ++q) { *(LAS unsigned short*)(VT + (8 * e8 + 2 * q) * GL_TROW + c * 2) = (unsigned short)(vv[q] & 0xffffu); *(LAS unsigned short*)(VT + (8 * e8 + 2 * q + 1) * GL_TROW + c * 2) = (unsigned short)(vv[q] >> 16); } }
}
__device__ __forceinline__ void gla_g1_unit(const Ctx& C, const Args& a, const bf16* __restrict__ P, int l, int ch) {
    const int h = ch & 3, n = (ch >> 2) & (NCHUNK - 1), b = ch >> 10, t0 = b * SEQ + n * GCH;
    float bl[16], blast;
    gla_decay(C, a, P, l, h, t0, bl, blast);
    const int d = C.tid & 127, cg = C.tid >> 7;
    LAS unsigned char* KET = C.lds + GL_KET;
#pragma unroll
    for (int i = 0; i < 16; ++i) { const int c = 16 * cg + i; const float k = bf2f(P[(size_t)(t0 + c) * NIN + PC_KG + h * GDK + d]);
        *(LAS unsigned short*)(KET + d * GL_TROW + c * 2) = (unsigned short)f2bf(k * expf(blast - bl[i])); }
    if (cg == 0) ((float*)(a.ws + WS_DEC))[(size_t)ch * GDK + d] = expf(blast);
    gla_stage_vt(C, P, h, t0);
    __syncthreads();
    const int r = C.lane & 31, hh = C.lane >> 5, w = C.wave;
    const LAS unsigned char* VT = C.lds + GL_VT;
    f32x16 acc[4];
#pragma unroll
    for (int db = 0; db < 4; ++db)
#pragma unroll
        for (int i = 0; i < 16; ++i) acc[db][i] = 0.f;
#pragma unroll
    for (int s = 0; s < 4; ++s) { const bf16x8 af = *(const LAS bf16x8*)(VT + (32 * w + r) * GL_TROW + (16 * s + 8 * hh) * 2);
#pragma unroll
        for (int db = 0; db < 4; ++db) { const bf16x8 bfr = *(const LAS bf16x8*)(KET + (32 * db + r) * GL_TROW + (16 * s + 8 * hh) * 2); acc[db] = MFMA32(af, bfr, acc[db]); } }
    float* kvt = (float*)(a.ws + WS_KVT) + (size_t)ch * (GDV * GDK);
#pragma unroll
    for (int db = 0; db < 4; ++db)
#pragma unroll
        for (int i = 0; i < 16; ++i) kvt[(size_t)(32 * w + crow(i, hh)) * GDK + 32 * db + r] = acc[db][i];
    __syncthreads();
}
__device__ __forceinline__ void gla_scan(const Ctx& C, const Args& a) {
    const float* __restrict__ KVT = (const float*)(a.ws + WS_KVT); const float* __restrict__ DEC = (const float*)(a.ws + WS_DEC); bf16* __restrict__ ST = (bf16*)(a.ws + WS_ST);
    for (int p = blockIdx.x * (NWAVES * 64) + C.tid; p < BATCH * GH * GDV * (GDK / 2); p += C.G * NWAVES * 64) {
        const int dp = p & 63, e = (p >> 6) & 255, bh = p >> 14, b = bh >> 2, h = bh & 3;
        float s0 = 0.f, s1 = 0.f;
#pragma unroll 8
        for (int n = 0; n < NCHUNK; ++n) { const size_t ch = (size_t)(b * NCHUNK + n) * GH + h; const size_t o = (ch * GDV + e) * GDK + 2 * dp;
            *(unsigned*)(ST + o) = pk2(s0, s1);
            const f32x2 kv = *(const f32x2*)(KVT + o), dc = *(const f32x2*)(DEC + ch * GDK + 2 * dp);
            s0 = dc.x * s0 + kv.x; s1 = dc.y * s1 + kv.y; }
    }
}
__device__ __forceinline__ void gla_g3_unit(const Ctx& C, const Args& a, const bf16* __restrict__ P, bf16* __restrict__ O, int l, int ch) {
    const int h = ch & 3, n = (ch >> 2) & (NCHUNK - 1), b = ch >> 10, t0 = b * SEQ + n * GCH;
    float bl[16], blast;
    gla_decay(C, a, P, l, h, t0, bl, blast);
    const int d = C.tid & 127, cg = C.tid >> 7;
    LAS unsigned char* QT = C.lds + GL_QT; LAS unsigned char* KT = C.lds + GL_KT; const LAS unsigned char* VT = C.lds + GL_VT;
#pragma unroll
    for (int i = 0; i < 16; ++i) { const int c = 16 * cg + i; const bf16* row = P + (size_t)(t0 + c) * NIN + h * GDK + d;
        const float q = bf2f(row[PC_QG]), k = bf2f(row[PC_KG]);
        *(LAS unsigned short*)(QT + c * GL_QROW + d * 2) = (unsigned short)f2bf(q * 0.08838834764831845f * expf(bl[i]));
        *(LAS unsigned short*)(KT + c * GL_QROW + d * 2) = (unsigned short)f2bf(k * expf(-bl[i])); }
    gla_stage_vt(C, P, h, t0);
    __syncthreads();
    const int r = C.lane & 31, hh = C.lane >> 5, w = C.wave;
    f32x16 z[2];
#pragma unroll
    for (int i = 0; i < 16; ++i) { z[0][i] = 0.f; z[1][i] = 0.f; }
    { const bf16* st = (const bf16*)(a.ws + WS_ST) + ((size_t)ch * GDV + 32 * w + r) * GDK + 8 * hh;
#pragma unroll
      for (int s = 0; s < 8; ++s) { const bf16x8 sf = *(const bf16x8*)(st + 16 * s);
#pragma unroll
          for (int cb = 0; cb < 2; ++cb) { const bf16x8 qf = *(const LAS bf16x8*)(QT + (32 * cb + r) * GL_QROW + (16 * s + 8 * hh) * 2); z[cb] = MFMA32(qf, sf, z[cb]); } } }
#pragma unroll
    for (int cb = 0; cb < 2; ++cb)
#pragma unroll
        for (int sb = 0; sb <= cb; ++sb) {
            f32x16 at;
#pragma unroll
            for (int i = 0; i < 16; ++i) at[i] = 0.f;
#pragma unroll
            for (int s = 0; s < 8; ++s) { const bf16x8 kf = *(const LAS bf16x8*)(KT + (32 * sb + r) * GL_QROW + (16 * s + 8 * hh) * 2), qf = *(const LAS bf16x8*)(QT + (32 * cb + r) * GL_QROW + (16 * s + 8 * hh) * 2); at = MFMA32(kf, qf, at); }
            if (sb == cb) {
#pragma unroll
                for (int i = 0; i < 16; ++i) at[i] = (crow(i, hh) <= r) ? at[i] : 0.f; }
#pragma unroll
            for (int st = 0; st < 2; ++st) { const bf16x8 pf = pack8(at, st, 1.0f);
                const LAS unsigned char* vp = VT + (32 * w + r) * GL_TROW + (32 * sb + 16 * st + 4 * hh) * 2;
                const s16x4 lo = *(const LAS s16x4*)vp, hi = *(const LAS s16x4*)(vp + 16);
                const bf16x8 vf = __builtin_shufflevector(lo, hi, 0, 1, 2, 3, 4, 5, 6, 7);
                z[cb] = MFMA32(pf, vf, z[cb]); }
        }
    __syncthreads();
    LAS float* OT = (LAS float*)(C.lds + GL_OT);
#pragma unroll
    for (int cb = 0; cb < 2; ++cb)
#pragma unroll
        for (int i = 0; i < 16; ++i) OT[(32 * cb + crow(i, hh)) * GL_OROW + 32 * w + r] = z[cb][i];
    __syncthreads();
    { const int c = C.tid >> 3, es = C.tid & 7;
      const LAS f32x4* orow = (const LAS f32x4*)(OT + c * GL_OROW + 32 * es);
      f32x4 v[8]; float ss = 0.f;
#pragma unroll
      for (int j = 0; j < 8; ++j) { v[j] = orow[j]; ss += (v[j].x * v[j].x + v[j].y * v[j].y) + (v[j].z * v[j].z + v[j].w * v[j].w); }
      ss += shx(ss, 1, C.lane); ss += shx(ss, 2, C.lane); ss += shx(ss, 4, C.lane);
      const float rinv = 1.0f / sqrtf(ss * (1.0f / GDV) + EPS);
      const bf16* rrow = P + (size_t)(t0 + c) * NIN + PC_RG + h * GDV + 32 * es;
      const float* nw = a.in[I_GNORM] + (size_t)l * GDV + 32 * es;
      bf16* orow_g = O + (size_t)(t0 + c) * D + D / 2 + h * GDV + 32 * es;
#pragma unroll
      for (int j = 0; j < 4; ++j) { const v4u rq = *(const v4u*)(rrow + 8 * j); const f32x4 w0 = *(const f32x4*)(nw + 8 * j), w1 = *(const f32x4*)(nw + 8 * j + 4);
          const unsigned rr[4] = {rq.x, rq.y, rq.z, rq.w}; const f32x4 x0 = v[2 * j], x1 = v[2 * j + 1];
          float y[8];
          const float r0 = bf2f(rr[0] & 0xffffu), r1 = bf2f(rr[0] >> 16), r2 = bf2f(rr[1] & 0xffffu), r3 = bf2f(rr[1] >> 16), r4 = bf2f(rr[2] & 0xffffu), r5 = bf2f(rr[2] >> 16), r6 = bf2f(rr[3] & 0xffffu), r7 = bf2f(rr[3] >> 16);
          y[0] = x0.x * rinv * w0.x * pg8::silu_f(r0); y[1] = x0.y * rinv * w0.y * pg8::silu_f(r1); y[2] = x0.z * rinv * w0.z * pg8::silu_f(r2); y[3] = x0.w * rinv * w0.w * pg8::silu_f(r3);
          y[4] = x1.x * rinv * w1.x * pg8::silu_f(r4); y[5] = x1.y * rinv * w1.y * pg8::silu_f(r5); y[6] = x1.z * rinv * w1.z * pg8::silu_f(r6); y[7] = x1.w * rinv * w1.w * pg8::silu_f(r7);
          v4u o; o.x = pk2(y[0], y[1]); o.y = pk2(y[2], y[3]); o.z = pk2(y[4], y[5]); o.w = pk2(y[6], y[7]);
          *(v4u*)(orow_g + 8 * j) = o; } }
    __syncthreads();
}

typedef short v4i16_t __attribute__((ext_vector_type(4)));
__device__ __forceinline__ s16x4 lds_tr16(const LAS unsigned char* p) { return __builtin_bit_cast(s16x4, __builtin_amdgcn_ds_read_tr16_b64_v4i16((LAS v4i16_t*)p)); }
__device__ __forceinline__ bf16x8 cat8(s16x4 lo, s16x4 hi) { return __builtin_shufflevector(lo, hi, 0, 1, 2, 3, 4, 5, 6, 7); }

constexpr int A2_K_OFF = 0, A2_V_OFF = 256 * 144, A2_O_OFF = A2_V_OFF + 256 * 128, A2_OROW = 144, A2_OWAVE = 32 * A2_OROW;
static_assert(A2_O_OFF + 8 * A2_OWAVE <= RING_BYTES, "attention LDS");
__device__ __forceinline__ void attn_unit2(const Ctx& C, const bf16* __restrict__ P, bf16* __restrict__ O, const float* sinks, int unit) {
    const int kv = unit & 1, n = (unit >> 1) & (NBLK - 1), b = unit >> 8;
    const int tb = b * SEQ + n * BLK;
    LAS unsigned char* KL = C.lds + A2_K_OFF; LAS unsigned char* VL = C.lds + A2_V_OFF; LAS unsigned char* OL = C.lds + A2_O_OFF + C.wave * A2_OWAVE;
    const int r = C.lane & 31, h = C.lane >> 5, head = kv * GQA + C.wave;
    v4u kq[4], vq[4];
#pragma unroll
    for (int j = 0; j < 4; ++j) { const int idx = C.tid + 512 * j, key = idx >> 3, part = idx & 7;
        kq[j] = (v4u){0u, 0u, 0u, 0u}; vq[j] = kq[j];
        if (n > 0 || key >= BLK) { const bf16* row = P + (size_t)(tb + key - BLK) * NIN; kq[j] = *(const v4u*)(row + PC_KA + kv * HD + 8 * part); vq[j] = *(const v4u*)(row + PC_VA + kv * HD + 8 * part); } }
    const bf16* qbase = P + (size_t)(tb + r) * NIN + PC_QA + head * HD + 8 * h;
    bf16x8 qf[4], qn[4];
#pragma unroll
    for (int s = 0; s < 4; ++s) { qf[s] = *(const bf16x8*)(qbase + 16 * s); qn[s] = qf[s]; }
#pragma unroll
    for (int j = 0; j < 4; ++j) { const int idx = C.tid + 512 * j, key = idx >> 3, part = idx & 7;
        *(LAS v4u*)(KL + key * 144 + part * 16) = kq[j];
        *(LAS v4u*)(VL + key * 128 + ((part * 16) ^ (((key >> 1) & 1) << 6))) = vq[j]; }
    __syncthreads();
    const float slope = exp2f(-0.5f * (float)(head + 1)) * 1.44269504089f, sink = sinks[head] * 1.44269504089f;
    const int ibase = r - 4 * h + BLK; const float nb = -slope * (float)ibase;
    const int tq = (C.lane & 15) >> 2, tp = C.lane & 3, tblk = (C.lane >> 4) & 1;
    const int vtr_off = tq * 128 + ((32 * tblk + 8 * tp) ^ (((tq >> 1) & 1) << 6));
#pragma unroll 1
    for (int qb = 0; qb < 4; ++qb) {
        if (qb < 3) {
#pragma unroll
            for (int s = 0; s < 4; ++s) qn[s] = *(const bf16x8*)(qbase + (size_t)(32 * (qb + 1)) * NIN + 16 * s); }
        f32x16 sa[5];
#pragma unroll
        for (int k5 = 0; k5 < 5; ++k5) {
#pragma unroll
            for (int i = 0; i < 16; ++i) sa[k5][i] = 0.f;
#pragma unroll
            for (int s = 0; s < 4; ++s) { const bf16x8 kf = *(const LAS bf16x8*)(KL + (32 * (qb + k5) + r) * 144 + (16 * s + 8 * h) * 2); sa[k5] = MFMA32(kf, qf[s], sa[k5]); } }
        float mx = -INFINITY;
#pragma unroll
        for (int k5 = 0; k5 < 5; ++k5)
#pragma unroll
            for (int i = 0; i < 16; ++i) { const int c = 32 * k5 + (i & 3) + 8 * (i >> 2);
                float v = __builtin_fmaf(sa[k5][i], 0.125f * 1.44269504089f, __builtin_fmaf(slope, (float)c, nb));
                if (k5 == 0) v = (ibase - c < WIN) ? v : -INFINITY;
                if (k5 == 4) v = (ibase >= c) ? v : -INFINITY;
                sa[k5][i] = v; }
        if (n == 0) {
#pragma unroll
            for (int k5 = 0; k5 < 5; ++k5)
#pragma unroll
                for (int i = 0; i < 16; ++i) { const int kj = 32 * (qb + k5) + crow(i, h); if (kj < BLK) sa[k5][i] = -INFINITY; } }
#pragma unroll
        for (int k5 = 0; k5 < 5; ++k5)
#pragma unroll
            for (int i = 0; i < 16; ++i) mx = fmaxf(mx, sa[k5][i]);
        mx = fmaxf(mx, shx(mx, 32, C.lane)); mx = fmaxf(mx, sink);
        float sum = 0.f;
#pragma unroll
        for (int k5 = 0; k5 < 5; ++k5)
#pragma unroll
            for (int i = 0; i < 16; ++i) { const float p = __builtin_amdgcn_exp2f(sa[k5][i] - mx); sa[k5][i] = p; sum += p; }
        sum += shx(sum, 32, C.lane); sum += __builtin_amdgcn_exp2f(sink - mx);
        const float inv = 1.0f / sum;
        f32x16 ot[2];
#pragma unroll
        for (int i = 0; i < 16; ++i) { ot[0][i] = 0.f; ot[1][i] = 0.f; }
#pragma unroll
        for (int k5 = 0; k5 < 5; ++k5)
#pragma unroll
            for (int st = 0; st < 2; ++st) { const bf16x8 pf = pack8(sa[k5], st, 1.0f);
                const int key0 = 32 * (qb + k5) + 16 * st + 4 * h;
#pragma unroll
                for (int db = 0; db < 2; ++db) { const LAS unsigned char* vp = VL + key0 * 128 + (vtr_off ^ (64 * db));
                    const bf16x8 vf = cat8(lds_tr16(vp), lds_tr16(vp + 8 * 128));
                    ot[db] = MFMA32(vf, pf, ot[db]); } }
#pragma unroll
        for (int db = 0; db < 2; ++db)
#pragma unroll
            for (int g = 0; g < 4; ++g) { v2u w; w.x = pk2(ot[db][4 * g] * inv, ot[db][4 * g + 1] * inv); w.y = pk2(ot[db][4 * g + 2] * inv, ot[db][4 * g + 3] * inv);
                *(LAS v2u*)(OL + r * A2_OROW + (32 * db + 8 * g + 4 * h) * 2) = w; }
#pragma unroll
        for (int j = 0; j < 4; ++j) { const int row = (C.lane >> 3) + 8 * j, part = C.lane & 7;
            const v4u w = *(const LAS v4u*)(OL + row * A2_OROW + part * 16);
            *(v4u*)(O + (size_t)(tb + 32 * qb + row) * D + head * HD + 8 * part) = w; }
#pragma unroll
        for (int s = 0; s < 4; ++s) qf[s] = qn[s];
    }
    __syncthreads();
}

constexpr int G2_QT = 0, G2_KT = 17408, G2_VR = 34816, G2_GLR = 67584, G2_TOT = 71680, G2_QROW = 272, G2_KEROW = 320, G2_OROW = 260;
static_assert(64 * G2_KEROW <= G2_VR && 64 * G2_OROW * 4 <= G2_GLR, "GLA LDS");
__device__ __forceinline__ void gla_decay2(const Ctx& C, const Args& a, unsigned glr, int l, int h, float (&bl)[16], float& blast) {
    LAS float* GLR = (LAS float*)(C.lds + G2_GLR); LAS float* TOT = (LAS float*)(C.lds + G2_TOT);
    const int d = C.tid & 127, cg = C.tid >> 7;
    GLR[2 * C.tid] = bf2f(glr & 0xffffu); GLR[2 * C.tid + 1] = bf2f(glr >> 16);
    float w2[16];
    const float* gw2 = a.in[I_GW2] + (size_t)l * GRANK * (GH * GDK) + h * GDK + d;
#pragma unroll
    for (int rr = 0; rr < 16; ++rr) w2[rr] = gw2[rr * (GH * GDK)];
    const float gb = a.in[I_GB][l * (GH * GDK) + h * GDK + d];
    __syncthreads();
    float run = 0.f;
#pragma unroll
    for (int i = 0; i < 16; ++i) { const LAS f32x4* g = (const LAS f32x4*)(GLR + (16 * cg + i) * 16); float z = gb;
#pragma unroll
        for (int q4 = 0; q4 < 4; ++q4) { const f32x4 gg = g[q4]; z += gg.x * w2[4 * q4] + gg.y * w2[4 * q4 + 1] + gg.z * w2[4 * q4 + 2] + gg.w * w2[4 * q4 + 3]; }
        const float ls = fminf(z, 0.f) - __logf(1.0f + __expf(-fabsf(z)));
        run += ls * (1.0f / 16.0f); bl[i] = run; }
    TOT[cg * 128 + d] = run;
    __syncthreads();
    float off = 0.f, tot = 0.f;
#pragma unroll
    for (int g = 0; g < 4; ++g) { const float t = TOT[g * 128 + d]; tot += t; if (g < cg) off += t; }
#pragma unroll
    for (int i = 0; i < 16; ++i) bl[i] += off;
    blast = tot;
}
__device__ __forceinline__ void gla_g1_unit2(const Ctx& C, const Args& a, const bf16* __restrict__ P, int l, int ch) {
    const int h = ch & 3, n = (ch >> 2) & (NCHUNK - 1), b = ch >> 10, t0 = b * SEQ + n * GCH;
    LAS unsigned char* KE = C.lds + G2_QT; LAS unsigned char* VR = C.lds + G2_VR;
    v4u kq[2], vq[4];
#pragma unroll
    for (int j = 0; j < 2; ++j) { const int idx = C.tid + 512 * j, c = idx >> 4, p16 = idx & 15; kq[j] = *(const v4u*)(P + (size_t)(t0 + c) * NIN + PC_KG + h * GDK + 8 * p16); }
#pragma unroll
    for (int j = 0; j < 4; ++j) { const int idx = C.tid + 512 * j, c = idx >> 5, e8 = idx & 31; vq[j] = *(const v4u*)(P + (size_t)(t0 + c) * NIN + PC_VG + h * GDV + 8 * e8); }
    const unsigned glr = *(const unsigned*)(P + (size_t)(t0 + (C.tid >> 3)) * NIN + PC_GL + 2 * (C.tid & 7));
#pragma unroll
    for (int j = 0; j < 2; ++j) { const int idx = C.tid + 512 * j, c = idx >> 4, p16 = idx & 15; *(LAS v4u*)(KE + c * G2_KEROW + 16 * p16) = kq[j]; }
#pragma unroll
    for (int j = 0; j < 4; ++j) { const int idx = C.tid + 512 * j, c = idx >> 5, e8 = idx & 31; *(LAS v4u*)(VR + c * 512 + ((16 * e8) ^ ((c & 3) << 6))) = vq[j]; }
    float bl[16], blast;
    gla_decay2(C, a, glr, l, h, bl, blast);
    const int d = C.tid & 127, cg = C.tid >> 7;
#pragma unroll
    for (int i = 0; i < 16; ++i) { LAS unsigned short* kp = (LAS unsigned short*)(KE + (16 * cg + i) * G2_KEROW + 2 * d); *kp = (unsigned short)f2bf(bf2f(*kp) * __expf(blast - bl[i])); }
    if (cg == 0) ((float*)(a.ws + WS_DEC))[(size_t)ch * GDK + d] = __expf(blast);
    __syncthreads();
    const int r = C.lane & 31, hh = C.lane >> 5, w = C.wave;
    const int tq = (C.lane & 15) >> 2, tp = C.lane & 3, tblk = (C.lane >> 4) & 1;
    f32x16 acc[4];
#pragma unroll
    for (int db = 0; db < 4; ++db)
#pragma unroll
        for (int i = 0; i < 16; ++i) acc[db][i] = 0.f;
#pragma unroll
    for (int s = 0; s < 4; ++s) { const int c0 = 16 * s + 8 * hh;
        const LAS unsigned char* vp = VR + (c0 + tq) * 512 + ((64 * w + 32 * tblk + 8 * tp) ^ (tq << 6));
        const bf16x8 af = cat8(lds_tr16(vp), lds_tr16(vp + 4 * 512));
#pragma unroll
        for (int db = 0; db < 4; ++db) { const LAS unsigned char* kp = KE + (c0 + tq) * G2_KEROW + 64 * db + 32 * tblk + 8 * tp;
            const bf16x8 bfr = cat8(lds_tr16(kp), lds_tr16(kp + 4 * G2_KEROW));
            acc[db] = MFMA32(af, bfr, acc[db]); } }
    float* kvt = (float*)(a.ws + WS_KVT) + (size_t)ch * (GDV * GDK);
#pragma unroll
    for (int db = 0; db < 4; ++db)
#pragma unroll
        for (int i = 0; i < 16; ++i) kvt[(size_t)(32 * w + crow(i, hh)) * GDK + 32 * db + r] = acc[db][i];
    __syncthreads();
}
__device__ __forceinline__ void gla_g3_unit2(const Ctx& C, const Args& a, const bf16* __restrict__ P, bf16* __restrict__ O, int l, int ch) {
    const int h = ch & 3, n = (ch >> 2) & (NCHUNK - 1), b = ch >> 10, t0 = b * SEQ + n * GCH;
    LAS unsigned char* QT = C.lds + G2_QT; LAS unsigned char* KT = C.lds + G2_KT; LAS unsigned char* VR = C.lds + G2_VR;
    const int r = C.lane & 31, hh = C.lane >> 5, w = C.wave;
    v4u qq[2], kq[2], vq[4];
#pragma unroll
    for (int j = 0; j < 2; ++j) { const int idx = C.tid + 512 * j, c = idx >> 4, p16 = idx & 15; const bf16* row = P + (size_t)(t0 + c) * NIN + h * GDK + 8 * p16; qq[j] = *(const v4u*)(row + PC_QG); kq[j] = *(const v4u*)(row + PC_KG); }
#pragma unroll
    for (int j = 0; j < 4; ++j) { const int idx = C.tid + 512 * j, c = idx >> 5, e8 = idx & 31; vq[j] = *(const v4u*)(P + (size_t)(t0 + c) * NIN + PC_VG + h * GDV + 8 * e8); }
    const unsigned glr = *(const unsigned*)(P + (size_t)(t0 + (C.tid >> 3)) * NIN + PC_GL + 2 * (C.tid & 7));
    bf16x8 sf[8];
    { const bf16* st = (const bf16*)(a.ws + WS_ST) + ((size_t)ch * GDV + 32 * w + r) * GDK + 8 * hh;
#pragma unroll
      for (int s = 0; s < 8; ++s) sf[s] = *(const bf16x8*)(st + 16 * s); }
    v4u rq[4];
    { const bf16* rrow = P + (size_t)(t0 + (C.tid >> 3)) * NIN + PC_RG + h * GDV + 32 * (C.tid & 7);
#pragma unroll
      for (int j = 0; j < 4; ++j) rq[j] = *(const v4u*)(rrow + 8 * j); }
#pragma unroll
    for (int j = 0; j < 2; ++j) { const int idx = C.tid + 512 * j, c = idx >> 4, p16 = idx & 15; *(LAS v4u*)(QT + c * G2_QROW + 16 * p16) = qq[j]; *(LAS v4u*)(KT + c * G2_QROW + 16 * p16) = kq[j]; }
#pragma unroll
    for (int j = 0; j < 4; ++j) { const int idx = C.tid + 512 * j, c = idx >> 5, e8 = idx & 31; *(LAS v4u*)(VR + c * 512 + ((16 * e8) ^ ((c & 3) << 6))) = vq[j]; }
    float bl[16], blast;
    gla_decay2(C, a, glr, l, h, bl, blast);
    { const int d = C.tid & 127, cg = C.tid >> 7;
#pragma unroll
      for (int i = 0; i < 16; ++i) { LAS unsigned short* qp = (LAS unsigned short*)(QT + (16 * cg + i) * G2_QROW + 2 * d); LAS unsigned short* kp = (LAS unsigned short*)(KT + (16 * cg + i) * G2_QROW + 2 * d);
          *qp = (unsigned short)f2bf(bf2f(*qp) * 0.08838834764831845f * __expf(bl[i])); *kp = (unsigned short)f2bf(bf2f(*kp) * __expf(-bl[i])); } }
    __syncthreads();
    const int tq = (C.lane & 15) >> 2, tp = C.lane & 3, tblk = (C.lane >> 4) & 1;
    f32x16 z[2];
#pragma unroll
    for (int i = 0; i < 16; ++i) { z[0][i] = 0.f; z[1][i] = 0.f; }
#pragma unroll
    for (int s = 0; s < 8; ++s)
#pragma unroll
        for (int cb = 0; cb < 2; ++cb) { const bf16x8 qf = *(const LAS bf16x8*)(QT + (32 * cb + r) * G2_QROW + (16 * s + 8 * hh) * 2); z[cb] = MFMA32(qf, sf[s], z[cb]); }
#pragma unroll
    for (int cb = 0; cb < 2; ++cb)
#pragma unroll
        for (int sb = 0; sb <= cb; ++sb) {
            f32x16 at;
#pragma unroll
            for (int i = 0; i < 16; ++i) at[i] = 0.f;
#pragma unroll
            for (int s = 0; s < 8; ++s) { const bf16x8 kf = *(const LAS bf16x8*)(KT + (32 * sb + r) * G2_QROW + (16 * s + 8 * hh) * 2), qf = *(const LAS bf16x8*)(QT + (32 * cb + r) * G2_QROW + (16 * s + 8 * hh) * 2); at = MFMA32(kf, qf, at); }
            if (sb == cb) {
#pragma unroll
                for (int i = 0; i < 16; ++i) at[i] = (crow(i, hh) <= r) ? at[i] : 0.f; }
#pragma unroll
            for (int st = 0; st < 2; ++st) { const bf16x8 pf = pack8(at, st, 1.0f);
                const int c0 = 32 * sb + 16 * st + 4 * hh;
                const LAS unsigned char* vp = VR + (c0 + tq) * 512 + ((64 * w + 32 * tblk + 8 * tp) ^ (tq << 6));
                const bf16x8 vf = cat8(lds_tr16(vp), lds_tr16(vp + 8 * 512));
                z[cb] = MFMA32(pf, vf, z[cb]); }
        }
    __syncthreads();
    LAS float* OT = (LAS float*)(C.lds + G2_QT);
#pragma unroll
    for (int cb = 0; cb < 2; ++cb)
#pragma unroll
        for (int i = 0; i < 16; ++i) OT[(32 * cb + crow(i, hh)) * G2_OROW + 32 * w + r] = z[cb][i];
    __syncthreads();
    { const int c = C.tid >> 3, es = C.tid & 7;
      const LAS f32x4* orow = (const LAS f32x4*)(OT + c * G2_OROW + 32 * es);
      f32x4 v[8]; float ss = 0.f;
#pragma unroll
      for (int j = 0; j < 8; ++j) { v[j] = orow[j]; ss += (v[j].x * v[j].x + v[j].y * v[j].y) + (v[j].z * v[j].z + v[j].w * v[j].w); }
      ss += shx(ss, 1, C.lane); ss += shx(ss, 2, C.lane); ss += shx(ss, 4, C.lane);
      const float rinv = 1.0f / sqrtf(ss * (1.0f / GDV) + EPS);
      const float* nw = a.in[I_GNORM] + (size_t)l * GDV + 32 * es;
      bf16* orow_g = O + (size_t)(t0 + c) * D + D / 2 + h * GDV + 32 * es;
#pragma unroll
      for (int j = 0; j < 4; ++j) { const f32x4 w0 = *(const f32x4*)(nw + 8 * j) * rinv, w1 = *(const f32x4*)(nw + 8 * j + 4) * rinv;
          const f32x4 x0 = v[2 * j], x1 = v[2 * j + 1];
          const float r0 = bf2f(rq[j].x & 0xffffu), r1 = bf2f(rq[j].x >> 16), r2 = bf2f(rq[j].y & 0xffffu), r3 = bf2f(rq[j].y >> 16), r4 = bf2f(rq[j].z & 0xffffu), r5 = bf2f(rq[j].z >> 16), r6 = bf2f(rq[j].w & 0xffffu), r7 = bf2f(rq[j].w >> 16);
          v4u o; o.x = pk2(x0.x * w0.x * pg8::silu_f(r0), x0.y * w0.y * pg8::silu_f(r1)); o.y = pk2(x0.z * w0.z * pg8::silu_f(r2), x0.w * w0.w * pg8::silu_f(r3));
          o.z = pk2(x1.x * w1.x * pg8::silu_f(r4), x1.y * w1.y * pg8::silu_f(r5)); o.w = pk2(x1.z * w1.z * pg8::silu_f(r6), x1.w * w1.w * pg8::silu_f(r7));
          *(v4u*)(orow_g + 8 * j) = o; } }
    __syncthreads();
}

constexpr int G3_NW = 94720 + 17 * 128 * 4;
static_assert(G3_NW + 1024 <= RING_BYTES, "G3 norm weights in LDS");
constexpr int G3_GW = 94720;
constexpr int GG = 8, NGRP = NCHUNK / GG;
constexpr int G3_QT = 0, G3_KT = 17408, G3_VR = 34816, G3_KE = 67584, G3_GLR = 88064, G3_TOT = 92160, G3_DL = 94208, G3_QROW = 272, G3_KEROW = 320, G3_OROW = 260;
static_assert(G3_KE + 64 * G3_KEROW <= G3_GLR && 64 * G3_OROW * 4 <= G3_KE && G3_DL + 512 <= RING_BYTES, "GLA group LDS");
__device__ __forceinline__ void gla_decay3(const Ctx& C, const Args& a, unsigned glr, int l, int h, float (&bl)[16], float& blast) {
    LAS float* GLR = (LAS float*)(C.lds + G3_GLR); LAS float* TOT = (LAS float*)(C.lds + G3_TOT);
    const int d = C.tid & 127, cg = C.tid >> 7;
    GLR[2 * C.tid] = bf2f(glr & 0xffffu); GLR[2 * C.tid + 1] = bf2f(glr >> 16);
    float w2[16];
    const LAS float* GW = (const LAS float*)(C.lds + G3_GW);
#pragma unroll
    for (int rr = 0; rr < 16; ++rr) w2[rr] = GW[rr * 128 + d];
    const float gb = GW[16 * 128 + d];
    __syncthreads();
    float run = 0.f;
#pragma unroll
    for (int i = 0; i < 16; ++i) { const LAS f32x4* g = (const LAS f32x4*)(GLR + (16 * cg + i) * 16); float z = gb;
#pragma unroll
        for (int q4 = 0; q4 < 4; ++q4) { const f32x4 gg = g[q4]; z += gg.x * w2[4 * q4] + gg.y * w2[4 * q4 + 1] + gg.z * w2[4 * q4 + 2] + gg.w * w2[4 * q4 + 3]; }
        const float ls = fminf(z, 0.f) - __logf(1.0f + __expf(-fabsf(z)));
        run += ls * (1.0f / 16.0f); bl[i] = run; }
    TOT[cg * 128 + d] = run;
    __syncthreads();
    float off = 0.f, tot = 0.f;
#pragma unroll
    for (int g = 0; g < 4; ++g) { const float t = TOT[g * 128 + d]; tot += t; if (g < cg) off += t; }
#pragma unroll
    for (int i = 0; i < 16; ++i) bl[i] += off;
    blast = tot;
}
__device__ __forceinline__ void gla_g1_grp(const Ctx& C, const Args& a, const bf16* __restrict__ P, int l, int gu) {
    const int h = gu & 3, grp = (gu >> 2) & (NGRP - 1), b = gu >> 7;
    LAS unsigned char* KE = C.lds + G3_KE; LAS unsigned char* VR = C.lds + G3_VR; LAS float* DL = (LAS float*)(C.lds + G3_DL);
    const int r = C.lane & 31, hh = C.lane >> 5, w = C.wave, d = C.tid & 127, cg = C.tid >> 7;
    const int tq = (C.lane & 15) >> 2, tp = C.lane & 3, tblk = (C.lane >> 4) & 1;
    f32x16 acc[4];
#pragma unroll
    for (int db = 0; db < 4; ++db)
#pragma unroll
        for (int i = 0; i < 16; ++i) acc[db][i] = 0.f;
    { LAS float* GW = (LAS float*)(C.lds + G3_GW);
#pragma unroll
      for (int k = 0; k < 4; ++k) { const int i = C.tid + 512 * k, rr = i >> 7, dd = i & 127; GW[i] = a.in[I_GW2][(size_t)l * GRANK * (GH * GDK) + rr * (GH * GDK) + h * GDK + dd]; }
      if (C.tid < 128) GW[16 * 128 + C.tid] = a.in[I_GB][l * (GH * GDK) + h * GDK + C.tid];
      __syncthreads(); }
    float bsum = 0.f;
    v4u kq[2], vq[4]; unsigned glr;
    { const int t0 = b * SEQ + (grp * GG) * GCH;
#pragma unroll
      for (int i = 0; i < 2; ++i) { const int idx = C.tid + 512 * i, c = idx >> 4, p16 = idx & 15; kq[i] = *(const v4u*)(P + (size_t)(t0 + c) * NIN + PC_KG + h * GDK + 8 * p16); }
#pragma unroll
      for (int i = 0; i < 4; ++i) { const int idx = C.tid + 512 * i, c = idx >> 5, e8 = idx & 31; vq[i] = *(const v4u*)(P + (size_t)(t0 + c) * NIN + PC_VG + h * GDV + 8 * e8); }
      glr = *(const unsigned*)(P + (size_t)(t0 + (C.tid >> 3)) * NIN + PC_GL + 2 * (C.tid & 7)); }
#pragma unroll 1
    for (int j = 0; j < GG; ++j) {
        const int t0 = b * SEQ + (grp * GG + j) * GCH;
#pragma unroll
        for (int i = 0; i < 2; ++i) { const int idx = C.tid + 512 * i, c = idx >> 4, p16 = idx & 15; *(LAS v4u*)(KE + c * G3_KEROW + 16 * p16) = kq[i]; }
#pragma unroll
        for (int i = 0; i < 4; ++i) { const int idx = C.tid + 512 * i, c = idx >> 5, e8 = idx & 31; *(LAS v4u*)(VR + c * 512 + ((16 * e8) ^ ((c & 3) << 6))) = vq[i]; }
        const unsigned glr_cur = glr;
        if (j + 1 < GG) { const int t1 = t0 + GCH;
#pragma unroll
            for (int i = 0; i < 2; ++i) { const int idx = C.tid + 512 * i, c = idx >> 4, p16 = idx & 15; kq[i] = *(const v4u*)(P + (size_t)(t1 + c) * NIN + PC_KG + h * GDK + 8 * p16); }
#pragma unroll
            for (int i = 0; i < 4; ++i) { const int idx = C.tid + 512 * i, c = idx >> 5, e8 = idx & 31; vq[i] = *(const v4u*)(P + (size_t)(t1 + c) * NIN + PC_VG + h * GDV + 8 * e8); }
            glr = *(const unsigned*)(P + (size_t)(t1 + (C.tid >> 3)) * NIN + PC_GL + 2 * (C.tid & 7)); }
        float bl[16], blast;
        gla_decay3(C, a, glr_cur, l, h, bl, blast);
        bsum += blast;
#pragma unroll
        for (int i = 0; i < 16; ++i) { LAS unsigned short* kp = (LAS unsigned short*)(KE + (16 * cg + i) * G3_KEROW + 2 * d); *kp = (unsigned short)f2bf(bf2f(*kp) * __expf(blast - bl[i])); }
        if (cg == 0) DL[d] = __expf(blast);
        __syncthreads();
#pragma unroll
        for (int db = 0; db < 4; ++db) { const float dc = DL[32 * db + r];
#pragma unroll
            for (int i = 0; i < 16; ++i) acc[db][i] *= dc; }
#pragma unroll
        for (int s = 0; s < 4; ++s) { const int c0 = 16 * s + 8 * hh;
            const LAS unsigned char* vp = VR + (c0 + tq) * 512 + ((64 * w + 32 * tblk + 8 * tp) ^ (tq << 6));
            const bf16x8 af = cat8(lds_tr16(vp), lds_tr16(vp + 4 * 512));
#pragma unroll
            for (int db = 0; db < 4; ++db) { const LAS unsigned char* kp = KE + (c0 + tq) * G3_KEROW + 64 * db + 32 * tblk + 8 * tp;
                const bf16x8 bfr = cat8(lds_tr16(kp), lds_tr16(kp + 4 * G3_KEROW));
                acc[db] = MFMA32(af, bfr, acc[db]); } }
        __syncthreads();
    }
    float* kvt = (float*)(a.ws + WS_KVT) + (size_t)gu * (GDV * GDK);
#pragma unroll
    for (int db = 0; db < 4; ++db)
#pragma unroll
        for (int i = 0; i < 16; ++i) kvt[(size_t)(32 * w + crow(i, hh)) * GDK + 32 * db + r] = acc[db][i];
    if (cg == 0) ((float*)(a.ws + WS_DEC))[(size_t)gu * GDK + d] = __expf(bsum);
}
__device__ __forceinline__ void tok0_row(const Ctx& C, const Args& a, const _Float16* hs, const float* w, const float* shv, const float* scv, int bstride) {
    float* u0 = (float*)(a.ws + WS_TOK0);
    if (C.gw < BATCH) { const int b = C.gw, m = b * SEQ;
        const h16x8n* xr = (const h16x8n*)(hs + (size_t)m * D) + C.lane; f32x4 v[8]; float s = 0.f;
#pragma unroll
        for (int j = 0; j < 4; ++j) { const f32x8n f = __builtin_convertvector(xr[64 * j], f32x8n); v[2 * j] = (f32x4){f[0], f[1], f[2], f[3]}; v[2 * j + 1] = (f32x4){f[4], f[5], f[6], f[7]}; }
#pragma unroll
        for (int j = 0; j < 8; ++j) s += (v[j].x * v[j].x + v[j].y * v[j].y) + (v[j].z * v[j].z + v[j].w * v[j].w);
        const float r = 1.0f / sqrtf(wave_sum(s, C.lane) * (1.0f / D) + EPS);
#pragma unroll
        for (int j = 0; j < 8; ++j) { const int col = 8 * (C.lane + 64 * (j >> 1)) + 4 * (j & 1);
            const f32x4 y = v[j] * r * (*(const f32x4*)(w + col) * (*(const f32x4*)(scv + (size_t)b * bstride + col) + 1.0f)) + *(const f32x4*)(shv + (size_t)b * bstride + col);
            *(f32x4*)(u0 + (size_t)b * D + col) = y; } }
}
constexpr int T0_PART = 8192;
__device__ __forceinline__ void tok0_qk_partial(const Ctx& C, const Args& a, int l) {
    const float* u0 = (const float*)(a.ws + WS_TOK0); float* part = (float*)(a.ws + WS_TOK0) + T0_PART;
    for (int it = C.gw; it < 64 * 16; it += C.NGW) { const int ks = it >> 4, cg = it & 15, col = 64 * cg + C.lane;
        const float* wp = a.in[I_WIN] + (size_t)l * D * NINR + (size_t)(32 * ks) * NINR + PC_QG + col;
        float wv[32];
#pragma unroll
        for (int j = 0; j < 32; ++j) wv[j] = wp[(size_t)j * NINR];
        const int ua = __builtin_bit_cast(int, u0[32 * ks + (C.lane & 31)]), ub = __builtin_bit_cast(int, u0[D + 32 * ks + (C.lane & 31)]);
        float s0 = 0.f, s1 = 0.f;
#pragma unroll
        for (int j = 0; j < 32; ++j) { s0 += __builtin_bit_cast(float, __builtin_amdgcn_readlane(ua, j)) * wv[j]; s1 += __builtin_bit_cast(float, __builtin_amdgcn_readlane(ub, j)) * wv[j]; }
        part[(size_t)(ks * 2 + 0) * 1024 + col] = s0; part[(size_t)(ks * 2 + 1) * 1024 + col] = s1; }
}
__device__ __forceinline__ void tok0_qk_reduce(const Ctx& C, const Args& a) {
    const float* part = (const float*)(a.ws + WS_TOK0) + T0_PART; float* qk0 = (float*)(a.ws + WS_TOK0) + BATCH * D;
    for (int id = C.gw; id < BATCH * 2 * GH * GDK; id += C.NGW) { const int b = id >> 10, col = id & 1023;
        const float s = wave_sum(part[(size_t)(C.lane * 2 + b) * 1024 + col], C.lane);
        qk0[(size_t)b * 1024 + col] = s; }
}
__device__ __forceinline__ void gla_scan_grp(const Ctx& C, const Args& a) {
    const float* __restrict__ KVT = (const float*)(a.ws + WS_KVT); const float* __restrict__ DEC = (const float*)(a.ws + WS_DEC); bf16* __restrict__ ST = (bf16*)(a.ws + WS_ST);
    for (int p = blockIdx.x * (NWAVES * 64) + C.tid; p < BATCH * GH * GDV * (GDK / 2); p += C.G * NWAVES * 64) {
        const int dp = p & 63, e = (p >> 6) & 255, bh = p >> 14, b = bh >> 2, h = bh & 3;
        f32x2 kv[NGRP], dc[NGRP];
#pragma unroll
        for (int g = 0; g < NGRP; ++g) { const size_t gu = (size_t)(b * NGRP + g) * GH + h; const size_t o = (gu * GDV + e) * GDK + 2 * dp;
            kv[g] = *(const f32x2*)(KVT + o); dc[g] = *(const f32x2*)(DEC + gu * GDK + 2 * dp); }
        float s0 = 0.f, s1 = 0.f;
#pragma unroll
        for (int g = 0; g < NGRP; ++g) { const size_t gu = (size_t)(b * NGRP + g) * GH + h; const size_t o = (gu * GDV + e) * GDK + 2 * dp;
            *(unsigned*)(ST + o) = pk2(s0, s1);
            s0 = dc[g].x * s0 + kv[g].x; s1 = dc[g].y * s1 + kv[g].y; }
    }
}
__device__ __forceinline__ void gla_g3_grp(const Ctx& C, const Args& a, const bf16* __restrict__ P, bf16* __restrict__ O, int l, int gu) {
    const int h = gu & 3, grp = (gu >> 2) & (NGRP - 1), b = gu >> 7;
    LAS unsigned char* QT = C.lds + G3_QT; LAS unsigned char* KT = C.lds + G3_KT; LAS unsigned char* VR = C.lds + G3_VR; LAS unsigned char* KE = C.lds + G3_KE; LAS float* DL = (LAS float*)(C.lds + G3_DL);
    const int w = C.wave;
    float a00 = 0.f;
    if (grp == 0) { const float* qk0 = (const float*)(a.ws + WS_TOK0) + BATCH * D + (size_t)b * 1024 + h * GDK;
        a00 = wave_sum(qk0[C.lane] * qk0[512 + C.lane] + qk0[64 + C.lane] * qk0[512 + 64 + C.lane], C.lane) * 0.08838834764831845f; }
    f32x16 S[4];
    { const int r = C.lane & 31, hh = C.lane >> 5;
      const bf16* st = (const bf16*)(a.ws + WS_ST) + ((size_t)gu * GDV + 32 * w + r) * GDK + 4 * hh;
#pragma unroll
      for (int db = 0; db < 4; ++db)
#pragma unroll
          for (int g = 0; g < 4; ++g) { const v2u x = *(const v2u*)(st + 32 * db + 8 * g);
              S[db][4 * g] = bf2f(x.x & 0xffffu); S[db][4 * g + 1] = bf2f(x.x >> 16); S[db][4 * g + 2] = bf2f(x.y & 0xffffu); S[db][4 * g + 3] = bf2f(x.y >> 16); } }
    { LAS float* GW = (LAS float*)(C.lds + G3_GW);
#pragma unroll
      for (int k = 0; k < 4; ++k) { const int i = C.tid + 512 * k, rr = i >> 7, dd = i & 127; GW[i] = a.in[I_GW2][(size_t)l * GRANK * (GH * GDK) + rr * (GH * GDK) + h * GDK + dd]; }
      if (C.tid < 128) GW[16 * 128 + C.tid] = a.in[I_GB][l * (GH * GDK) + h * GDK + C.tid];
      if (C.tid >= 256) ((LAS float*)(C.lds + G3_NW))[C.tid - 256] = a.in[I_GNORM][(size_t)l * GDV + C.tid - 256];
      __syncthreads(); }
    v4u qq[2], kq[2]; unsigned glr;
#define G3_LOADQK(tt0, tid_) do { \
        glr = *(const unsigned*)(P + (size_t)((tt0) + ((tid_) >> 3)) * NIN + PC_GL + 2 * ((tid_) & 7)); \
        _Pragma("unroll") for (int i = 0; i < 2; ++i) { const int idx = (tid_) + 512 * i, c = idx >> 4, p16 = idx & 15; const bf16* row = P + (size_t)((tt0) + c) * NIN + h * GDK + 8 * p16; qq[i] = *(const v4u*)(row + PC_QG); kq[i] = *(const v4u*)(row + PC_KG); } } while (0)
    { int tid0_ = C.tid; asm volatile("" : "+v"(tid0_)); G3_LOADQK(b * SEQ + grp * GG * GCH, tid0_); }
#pragma unroll 1
    for (int j = 0; j < GG; ++j) {
        const int t0 = b * SEQ + (grp * GG + j) * GCH;
        int tid_ = C.tid; asm volatile("" : "+v"(tid_));
        Ctx C2 = C; C2.tid = tid_; C2.lane = tid_ & 63;
        const int lane = tid_ & 63, r = lane & 31, hh = lane >> 5, d = tid_ & 127, cg = tid_ >> 7;
        const int tq = (lane & 15) >> 2, tp = lane & 3, tblk = (lane >> 4) & 1;
        v4u vq[4], rq[4];
#pragma unroll
        for (int i = 0; i < 4; ++i) { const int idx = tid_ + 512 * i, c = idx >> 5, e8 = idx & 31; vq[i] = *(const v4u*)(P + (size_t)(t0 + c) * NIN + PC_VG + h * GDV + 8 * e8); }
        float bl[16], blast;
        gla_decay3(C2, a, glr, l, h, bl, blast);
#pragma unroll
        for (int i = 0; i < 2; ++i) { const int idx = tid_ + 512 * i, c = idx >> 4, p16 = idx & 15; *(LAS v4u*)(QT + c * G3_QROW + 16 * p16) = qq[i]; *(LAS v4u*)(KT + c * G3_QROW + 16 * p16) = kq[i]; }
        __syncthreads();
#pragma unroll
        for (int i = 0; i < 16; ++i) { LAS unsigned short* qp = (LAS unsigned short*)(QT + (16 * cg + i) * G3_QROW + 2 * d); LAS unsigned short* kp = (LAS unsigned short*)(KT + (16 * cg + i) * G3_QROW + 2 * d);
            const float kraw = bf2f(*kp);
            *qp = (unsigned short)f2bf(bf2f(*qp) * 0.08838834764831845f * __expf(bl[i])); *kp = (unsigned short)f2bf(kraw * __expf(-bl[i]));
            *(LAS unsigned short*)(KE + (16 * cg + i) * G3_KEROW + 2 * d) = (unsigned short)f2bf(kraw * __expf(blast - bl[i])); }
        if (cg == 0) DL[d] = __expf(blast);
#pragma unroll
        for (int i = 0; i < 4; ++i) { const int idx = tid_ + 512 * i, c = idx >> 5, e8 = idx & 31; *(LAS v4u*)(VR + c * 512 + ((16 * e8) ^ ((c & 3) << 6))) = vq[i]; }
        __syncthreads();
        { const bf16* rrow = P + (size_t)(t0 + (tid_ >> 3)) * NIN + PC_RG + h * GDV + 32 * (tid_ & 7);
#pragma unroll
          for (int i = 0; i < 4; ++i) rq[i] = *(const v4u*)(rrow + 8 * i); }
        f32x16 z[2];
#pragma unroll
        for (int i = 0; i < 16; ++i) { z[0][i] = 0.f; z[1][i] = 0.f; }
#pragma unroll
        for (int db = 0; db < 4; ++db)
#pragma unroll
            for (int st = 0; st < 2; ++st) { const bf16x8 sfr = pack8(S[db], st, 1.0f);
#pragma unroll
                for (int cb = 0; cb < 2; ++cb) { const LAS unsigned char* qp = QT + (32 * cb + r) * G3_QROW + (32 * db + 16 * st + 4 * hh) * 2;
                    const bf16x8 qf = cat8(*(const LAS s16x4*)qp, *(const LAS s16x4*)(qp + 16));
                    z[cb] = MFMA32(qf, sfr, z[cb]); } }
#pragma unroll
        for (int cb = 0; cb < 2; ++cb)
#pragma unroll
            for (int sb = 0; sb <= cb; ++sb) {
                f32x16 at;
#pragma unroll
                for (int i = 0; i < 16; ++i) at[i] = 0.f;
#pragma unroll
                for (int s = 0; s < 8; ++s) { const bf16x8 kf = *(const LAS bf16x8*)(KT + (32 * sb + r) * G3_QROW + (16 * s + 8 * hh) * 2), qf = *(const LAS bf16x8*)(QT + (32 * cb + r) * G3_QROW + (16 * s + 8 * hh) * 2); at = MFMA32(kf, qf, at); }
                if (sb == cb) {
#pragma unroll
                    for (int i = 0; i < 16; ++i) at[i] = (crow(i, hh) <= r) ? at[i] : 0.f; }
                if (sb == 0 && cb == 0 && grp == 0 && j == 0 && lane == 0) at[0] = a00;
#pragma unroll
                for (int st = 0; st < 2; ++st) { const bf16x8 pf = pack8(at, st, 1.0f);
                    const int c0 = 32 * sb + 16 * st + 4 * hh;
                    const LAS unsigned char* vp = VR + (c0 + tq) * 512 + ((64 * w + 32 * tblk + 8 * tp) ^ (tq << 6));
                    const bf16x8 vf = cat8(lds_tr16(vp), lds_tr16(vp + 8 * 512));
                    z[cb] = MFMA32(pf, vf, z[cb]); }
            }
        if (j + 1 < GG) {
#pragma unroll
            for (int db = 0; db < 4; ++db)
#pragma unroll
                for (int g = 0; g < 4; ++g) { const f32x4 dc = *(const LAS f32x4*)(DL + 32 * db + 8 * g + 4 * hh);
                    S[db][4 * g] *= dc.x; S[db][4 * g + 1] *= dc.y; S[db][4 * g + 2] *= dc.z; S[db][4 * g + 3] *= dc.w; }
#pragma unroll
            for (int s = 0; s < 4; ++s) { const int c0 = 16 * s + 8 * hh;
                const LAS unsigned char* vp = VR + (c0 + tq) * 512 + ((64 * w + 32 * tblk + 8 * tp) ^ (tq << 6));
                const bf16x8 vfr = cat8(lds_tr16(vp), lds_tr16(vp + 4 * 512));
#pragma unroll
                for (int db = 0; db < 4; ++db) { const LAS unsigned char* kp = KE + (c0 + tq) * G3_KEROW + 64 * db + 32 * tblk + 8 * tp;
                    const bf16x8 kfr = cat8(lds_tr16(kp), lds_tr16(kp + 4 * G3_KEROW));
                    S[db] = MFMA32(kfr, vfr, S[db]); } }
        }
        if (j + 1 < GG) G3_LOADQK(t0 + GCH, tid_);
        __syncthreads();
        LAS float* OT = (LAS float*)(C.lds + G3_QT);
#pragma unroll
        for (int cb = 0; cb < 2; ++cb)
#pragma unroll
            for (int i = 0; i < 16; ++i) OT[(32 * cb + crow(i, hh)) * G3_OROW + 32 * w + r] = z[cb][i];
        __syncthreads();
        { const int c = tid_ >> 3, es = tid_ & 7;
          const LAS f32x4* orow = (const LAS f32x4*)(OT + c * G3_OROW + 32 * es);
          f32x4 v[8]; float ss = 0.f;
#pragma unroll
          for (int i = 0; i < 8; ++i) { v[i] = orow[i]; ss += (v[i].x * v[i].x + v[i].y * v[i].y) + (v[i].z * v[i].z + v[i].w * v[i].w); }
          ss += shx(ss, 1, lane); ss += shx(ss, 2, lane); ss += shx(ss, 4, lane);
          const float rinv = 1.0f / sqrtf(ss * (1.0f / GDV) + EPS);
          const LAS float* nw = (const LAS float*)(C.lds + G3_NW) + 32 * es;
          bf16* orow_g = O + (size_t)(t0 + c) * D + D / 2 + h * GDV + 32 * es;
#pragma unroll
          for (int i = 0; i < 4; ++i) { const f32x4 w0 = *(const LAS f32x4*)(nw + 8 * i) * rinv, w1 = *(const LAS f32x4*)(nw + 8 * i + 4) * rinv;
              const f32x4 x0 = v[2 * i], x1 = v[2 * i + 1];
              const float r0 = bf2f(rq[i].x & 0xffffu), r1 = bf2f(rq[i].x >> 16), r2 = bf2f(rq[i].y & 0xffffu), r3 = bf2f(rq[i].y >> 16), r4 = bf2f(rq[i].z & 0xffffu), r5 = bf2f(rq[i].z >> 16), r6 = bf2f(rq[i].w & 0xffffu), r7 = bf2f(rq[i].w >> 16);
              v4u o; o.x = pk2(x0.x * w0.x * pg8::silu_f(r0), x0.y * w0.y * pg8::silu_f(r1)); o.y = pk2(x0.z * w0.z * pg8::silu_f(r2), x0.w * w0.w * pg8::silu_f(r3));
              o.z = pk2(x1.x * w1.x * pg8::silu_f(r4), x1.y * w1.y * pg8::silu_f(r5)); o.w = pk2(x1.z * w1.z * pg8::silu_f(r6), x1.w * w1.w * pg8::silu_f(r7));
              *(v4u*)(orow_g + 8 * i) = o; } }
        __syncthreads();
    }
}

#ifndef PROBE_MASK
#define PROBE_MASK 0
#endif
#define REP(bit) for (int rep_ = 0; rep_ < (((PROBE_MASK) >> (bit)) & 1) + 1; ++rep_)
#define FRESH_CTX(Cn) Ctx Cn = C; { int t_ = threadIdx.x, g_ = C.gw; asm volatile("" : "+v"(t_), "+s"(g_)); Cn.tid = t_; Cn.lane = t_ & 63; Cn.gw = g_; }
__global__ void __launch_bounds__(NWAVES * 64, 2) hybrid_fwd(Args args) {
    extern __shared__ __attribute__((aligned(16))) unsigned char lds[];
    Ctx C;
    C.lds = (LAS unsigned char*)lds;
    C.tid = threadIdx.x; C.lane = C.tid & 63; C.wave = __builtin_amdgcn_readfirstlane(C.tid >> 6);
    C.G = gridDim.x; { const int bx = blockIdx.x; const int vcu = (C.G % 8 == 0) ? (bx % 8) * (C.G / 8) + bx / 8 : bx; C.gw = vcu * NWAVES + C.wave; C.NGW = C.G * NWAVES; }
    volatile LAS unsigned* MISC = (volatile LAS unsigned*)(C.lds + MISC_OFF);
    unsigned char* ws = args.ws;
    gu32* ctl = (gu32*)(ws + WS_CTL);
    for (int u = C.tid; u < (LDS_BYTES - LDSCTL_OFF) / 4; u += NWAVES * 64) ((LAS unsigned*)(C.lds + LDSCTL_OFF))[u] = 0u;
    __syncthreads();
    XcdBarrier bar; bar.bar = (unsigned*)(ctl + CW_BAR); bar.x = 0; bar.st = nullptr;
    if (MK_N_LAUNCHES == 1) bar = xcd_barrier_post((unsigned*)(ctl + CW_BAR), MISC + 8);
    const int lo = args.ph_lo, hi = args.ph_hi;
#define IN(k) (lo <= (k) && (k) < hi)
#define SEAM(k) do { if (MK_N_LAUNCHES == 1) { if (IN((k) + 1)) xcd_barrier(bar); } } while (0)

    const float* modp = (const float*)(ws + WS_MOD); const float* fmodp = (const float*)(ws + WS_FMOD);
    bf16* U = (bf16*)(ws + WS_U); bf16* HID = (bf16*)(ws + WS_HID); bf16* P = (bf16*)(ws + WS_HID); bf16* OMIX = (bf16*)(ws + WS_OMIX); _Float16* HS = (_Float16*)(ws + WS_H); signed char* U8 = (signed char*)(ws + WS_U); float* SROW = (float*)(ws + WS_SROW);

    if (IN(0)) {
#ifndef DIS_P0MOD
 REP(0) { FRESH_CTX(Cp) p0_mod(Cp, args); }
#endif
 { FRESH_CTX(Cp) p0_phase_a(Cp, args, MISC + 16); }
 SEAM(0); }

#pragma unroll 1
    for (int l = 0; l < DEPTH; ++l) {
        const int pb = 1 + 12 * l;
        const float* modl = modp + (size_t)l * BATCH * NMOD * D;
        unsigned char* wl = ws + WS_W + (size_t)l * W_LAYER;
#pragma unroll 1
        for (int f = 0; f < 2; ++f) {
            const int pf = pb + (f ? 9 : 0), sub = f ? 2 : 0;
            if (IN(pf + 0)) {
                const float* src = (l == 0 && f == 0) ? args.in[I_X] : args.out;
#ifndef DIS_NORM
                if (l == 0 && f == 0) { REP(1) { FRESH_CTX(Cp) norm_q8<true>(Cp, args.in[I_X], args.in[I_NFFN1], modl + 0 * D, modl + 1 * D, NMOD * D, U8, SROW); } }
                else { REP(1) { FRESH_CTX(Cp) norm_q8<false>(Cp, HS, args.in[f ? I_NFFN2 : I_NFFN1] + (size_t)l * D, modl + (3 * sub + 0) * D, modl + (3 * sub + 1) * D, NMOD * D, U8, SROW); } }
#endif
                SEAM(pf + 0);
            }
            if (IN(pf + 1)) {
                pg8::Gemm g{(const bf16*)U8, (const bf16*)(wl + f * W_FFN), M, NUP, D / 2};
                pg8::StaticOrder S; S.init(M, NUP, C.G, (int)blockIdx.x);
                pg8::EpiSwiGLU8 E{HID, FF, SROW, (const float*)(ws + WS_SCOL) + (size_t)(l * 2 + f) * NUP};
#ifndef DIS_UP
                REP(2) pg8::gemm_phase<pg8::EpiSwiGLU8, pg8::StaticOrder, GEMM_ALIGN, GEMM_SP2>(C.lds + RING_OFF, g, S, E);
#endif
                SEAM(pf + 1);
            }
            if (IN(pf + 2)) {
                pg8::Gemm g{HID, (const bf16*)(wl + f * W_FFN + W_DN), M, D, FF}; DN_ORDER S; S.init(M, D, C.G, (int)blockIdx.x);
                if (l == 0 && f == 0) { pg8::EpiResidH<true, true> E{args.in[I_X], HS, modl + (3 * sub + 2) * D, D, NMOD * D};
                    pg8::gemm_phase<pg8::EpiResidH<true, true>, DN_ORDER, GEMM_ALIGN, GEMM_SP2>(C.lds + RING_OFF, g, S, E); }
                else { pg8::EpiResidH<false, true> E{HS, HS, modl + (3 * sub + 2) * D, D, NMOD * D};
                    pg8::gemm_phase<pg8::EpiResidH<false, true>, DN_ORDER, GEMM_ALIGN, GEMM_SP2>(C.lds + RING_OFF, g, S, E); }
                SEAM(pf + 2);
            }
            if (f == 0) {
                if (IN(pb + 3)) {
#ifndef DIS_NORM
                    REP(1) { FRESH_CTX(Cp) norm_phase_h<false>(Cp, HS, args.in[I_NMIX] + (size_t)l * D, modl + 3 * D, modl + 4 * D, NMOD * D, U, nullptr); }
                    { FRESH_CTX(Cp) tok0_row(Cp, args, HS, args.in[I_NMIX] + (size_t)l * D, modl + 3 * D, modl + 4 * D, NMOD * D); }
#endif
                    SEAM(pb + 3);
                }
                if (IN(pb + 4)) {
                    pg8::Gemm g{U, (const bf16*)(wl + W_IN), M, NIN, D}; pg8::StaticOrder S; S.init(M, NIN, C.G, (int)blockIdx.x);
                    pg8::EpiBf16 E{P, NIN};
#ifndef DIS_IN
                    REP(3) pg8::gemm_phase<pg8::EpiBf16, pg8::StaticOrder, GEMM_ALIGN, GEMM_SP2>(C.lds + RING_OFF, g, S, E);
#endif
                    SEAM(pb + 4);
                }
                if (IN(pb + 5)) {
                    #ifndef DIS_ATTN
                    { FRESH_CTX(Cp) tok0_qk_partial(Cp, args, l); }
                    REP(4) { FRESH_CTX(Cp) for (int u = blockIdx.x; u < BATCH * NBLK * NKV; u += C.G) attn_unit2(Cp, P, OMIX, args.in[I_SINK] + l * NQH, u); }
#endif
                    #ifndef DIS_G1
                    REP(5) { FRESH_CTX(Cp) for (int gu = blockIdx.x; gu < BATCH * NGRP * GH; gu += C.G) gla_g1_grp(Cp, args, P, l, gu); }
#endif
                    SEAM(pb + 5);
                }
                if (IN(pb + 6)) {
                    { FRESH_CTX(Cp) tok0_qk_reduce(Cp, args); }
#ifndef DIS_SCAN
 REP(6) { FRESH_CTX(Cp) gla_scan_grp(Cp, args); }
#endif
 SEAM(pb + 6); }
                if (IN(pb + 7)) {
                    #ifndef DIS_G3
                    REP(7) { FRESH_CTX(Cp) for (int gu = blockIdx.x; gu < BATCH * NGRP * GH; gu += C.G) gla_g3_grp(Cp, args, P, OMIX, l, gu); }
#endif
                    SEAM(pb + 7);
                }
                if (IN(pb + 8)) {
                    pg8::Gemm g{OMIX, (const bf16*)(wl + W_OUT), M, D, D}; pg8::StaticOrder S; S.init(M, D, C.G, (int)blockIdx.x);
                    pg8::EpiResidH<false, false> E{HS, HS, modl + 5 * D, D, NMOD * D};
                    pg8::gemm_phase<pg8::EpiResidH<false, false>, pg8::StaticOrder, GEMM_ALIGN, GEMM_SP2>(C.lds + RING_OFF, g, S, E);
                    SEAM(pb + 8);
                }
            }
        }
    }
#ifndef DIS_NORM
    if (IN(NPH - 1)) { FRESH_CTX(Cp) norm_phase_h<true>(Cp, HS, args.in[I_FNORM], fmodp, fmodp + D, 2 * D, nullptr, args.out); }
#endif
#ifdef PROBE_WAIT
    {
        if (threadIdx.x == 0) { const unsigned w = MISC[12]; atomicAdd((unsigned*)(ctl + 8192), w); atomicMax((unsigned*)(ctl + 8193), ~0u - w); atomicMax((unsigned*)(ctl + 8194), w); atomicAdd((unsigned*)(ctl + 8195), MISC[13]); if (blockIdx.x == 0) atomicAdd((unsigned*)(ctl + 8196), MISC[15]); }
        xcd_barrier(bar);
        if (threadIdx.x == 0) {
            const unsigned sum = __hip_atomic_load((unsigned*)(ctl + 8192), RLX_AGENT), mn = ~0u - __hip_atomic_load((unsigned*)(ctl + 8193), RLX_AGENT), mx = __hip_atomic_load((unsigned*)(ctl + 8194), RLX_AGENT);
            const unsigned v = PROBE_WSEL == 0 ? sum / gridDim.x : PROBE_WSEL == 1 ? mn : PROBE_WSEL == 2 ? mx : PROBE_WSEL == 3 ? __hip_atomic_load((unsigned*)(ctl + 8195), RLX_AGENT) / 8 : __hip_atomic_load((unsigned*)(ctl + 8196), RLX_AGENT);
            const unsigned long long t0 = wall_clock64();
            while (wall_clock64() - t0 < (unsigned long long)v * PROBE_WAIT) __builtin_amdgcn_s_sleep(8);
        }
        __syncthreads();
    }
#endif
#undef IN
#undef SEAM
}

extern "C" void kernel_launch(void* const* d_in, const int* in_sizes, int n_in, void* d_out, int out_size, void* d_ws, size_t ws_size, hipStream_t stream) {
    static int grid = 0;
    if (grid == 0) {
        if (n_in != 22 || in_sizes[0] != M * D || out_size != M * D || ws_size < WS_END) { fprintf(stderr, "kernel_launch: unexpected shapes (n_in %d, in0 %d, out %d, ws %zu); nothing launched\n", n_in, n_in > 0 ? in_sizes[0] : -1, out_size, ws_size); grid = -1; return; }
        int dev = 0, cus = 0, per_cu = 0;
        if (hipGetDevice(&dev) != hipSuccess || hipDeviceGetAttribute(&cus, hipDeviceAttributeMultiprocessorCount, dev) != hipSuccess) { grid = -1; return; }
        if (hipFuncSetAttribute((const void*)hybrid_fwd, hipFuncAttributeMaxDynamicSharedMemorySize, LDS_BYTES) != hipSuccess) { fprintf(stderr, "kernel_launch: hipFuncSetAttribute failed\n"); grid = -1; return; }
        if (hipOccupancyMaxActiveBlocksPerMultiprocessor(&per_cu, (const void*)hybrid_fwd, NWAVES * 64, LDS_BYTES) != hipSuccess || per_cu < 1) { fprintf(stderr, "kernel_launch: occupancy query says %d blocks per CU; nothing launched\n", per_cu); (void)hipGetLastError(); grid = -1; return; }
        grid = cus;
    }
    if (grid < 0) return;
    if (hipMemsetAsync((char*)d_ws + WS_CTL, 0, CTL_ZERO_BYTES, stream) != hipSuccess) return;
    Args a{};
    for (int i = 0; i < 22; ++i) a.in[i] = (const float*)d_in[i];
    a.out = (float*)d_out; a.ws = (unsigned char*)d_ws; a.li = 0; a.pad = 0;
    if (MK_N_LAUNCHES == 1) { a.ph_lo = 0; a.ph_hi = NPH; hipLaunchKernelGGL(hybrid_fwd, dim3(grid), dim3(NWAVES * 64), LDS_BYTES, stream, a); }
    else for (int p = 0; p < NPH; ++p) { a.ph_lo = p; a.ph_hi = p + 1; hipLaunchKernelGGL(hybrid_fwd, dim3(grid), dim3(NWAVES * 64), LDS_BYTES, stream, a); }
}
```

```cpp
#define GEMM_WGM 4
#include <hip/hip_runtime.h>
#include <cstdio>
#include <cstdint>
constexpr int BATCH = 2, SEQ = 16384, D = 2048, DEPTH = 4, M = BATCH * SEQ, FF = 5632, NUP = 2 * FF, NINR = 4368, NIN = 4608;
constexpr int NQH = 16, NKV = 2, HD = 64, GQA = 8, WIN = 128, BLK = 128, NBLK = SEQ / BLK;
constexpr int GH = 4, GDK = 128, GDV = 256, GRANK = 16, GCH = 64, NCHUNK = SEQ / GCH;
constexpr int NMOD = 9;
constexpr float EPS = 1e-6f;
constexpr int PC_QA = 0, PC_KA = 1024, PC_VA = 1152, PC_QG = 1280, PC_KG = 1792, PC_VG = 2304, PC_RG = 3328, PC_GL = 4352;
#ifndef GEMM_WGM
#define GEMM_WGM 8
#endif
namespace pg8 {
#define PG8_LAS __attribute__((address_space(3)))
typedef unsigned short bf16_t;
typedef short bf16x8 __attribute__((ext_vector_type(8)));
typedef float f32x4 __attribute__((ext_vector_type(4)));
typedef unsigned u32x4 __attribute__((ext_vector_type(4)));
typedef int i32x4 __attribute__((ext_vector_type(4)));
constexpr int BM = 256, BK = 64, HALF = 128, HTB = HALF * BK * 2  , STAGE_BYTES = 8 * HTB, NXCD = 8, WGM = GEMM_WGM;

__host__ __device__ __forceinline__ int lds_byte(int r, int c) { const int st = (r >> 4) * 2 + (c >> 5), rr = r & 15, cc = c & 31, ob = rr * 64 + cc * 2; return st * 1024 + (ob ^ (((ob >> 9) & 1) << 5)); }
__host__ __device__ __forceinline__ void stage_rc(int b, int& R, int& C) { const int st = b / 1024, sb = b % 1024, swz = sb ^ (((sb >> 9) & 1) << 5); R = (st >> 1) * 16 + swz / 64; C = (st & 1) * 32 + (swz % 64) / 2; }
__host__ __device__ __forceinline__ int perm32(int rho) { const int n = rho >> 4, i = rho & 15; return 8 * (i >> 2) + 4 * n + (i & 3); }

struct Unit { int pm, pn; };
struct Gemm { const bf16_t* A; const bf16_t* Bt; int M, N, K; };

struct StaticOrder {
    int nM, nN, nwg, G, c;
    __host__ __device__ void init(int M, int N, int G_, int c_) { nM = M / BM; nN = N / BM; nwg = nM * nN; G = G_; c = c_; }
    __host__ __device__ bool next(int i, Unit& u) const {
        const long L = (long)i * G + c; if (L >= nwg) return false;
        int wgid = (int)L; { const int q = nwg / NXCD, r = nwg % NXCD, xcd = wgid % NXCD, off = wgid / NXCD; wgid = (xcd < r ? xcd * (q + 1) : r * (q + 1) + (xcd - r) * q) + off; }
        const int nig = WGM * nN, gid = wgid / nig, fm = gid * WGM, gsz = (nM - fm) < WGM ? (nM - fm) : WGM;
        u.pm = fm + ((wgid % nig) % gsz); u.pn = (wgid % nig) / gsz; return true;
    }
    __device__ __forceinline__ void a_ready(const Unit&) const {}
    __device__ __forceinline__ void done(const Unit&) const {}
};
struct StaticOrderRev : StaticOrder {
    __host__ __device__ bool next(int i, Unit& u) const { if (!StaticOrder::next(i, u)) return false; u.pm = nM - 1 - u.pm; return true; }
};

__device__ __forceinline__ unsigned cvt_pk_bf16(float lo, float hi) { unsigned r; asm volatile("v_cvt_pk_bf16_f32 %0, %1, %2" : "=v"(r) : "v"(lo), "v"(hi)); return r; }
typedef float f32x2 __attribute__((ext_vector_type(2)));
typedef __bf16 bf16x2n __attribute__((ext_vector_type(2)));
__device__ __forceinline__ unsigned cvtpk(float lo, float hi) { f32x2 v = {lo, hi}; bf16x2n b = __builtin_convertvector(v, bf16x2n); return __builtin_bit_cast(unsigned, b); }
__device__ __forceinline__ float silu_f(float x) { return x * __builtin_amdgcn_rcpf(1.0f + __builtin_amdgcn_exp2f(-1.44269504089f * x)); }

struct EpiBf16 {
    static constexpr bool PERM = true, AFTER_DRAIN = false;
    bf16_t* O; int ldc;
    __device__ __forceinline__ void operator()(const f32x4 (&acc)[2][2][4][2], const Unit& u, int wr, int wc, int fr, int fq) const {
        const int row0 = u.pm * BM + wr * 64 + fr, col0 = u.pn * BM + wc * 32 + 8 * fq;
#pragma unroll
        for (int ai = 0; ai < 2; ++ai)
#pragma unroll
            for (int m = 0; m < 4; ++m) { bf16_t* rowp = O + (size_t)(row0 + ai * HALF + m * 16) * ldc + col0;
#pragma unroll
                for (int bj = 0; bj < 2; ++bj) { const f32x4 v0 = acc[ai][bj][m][0], v1 = acc[ai][bj][m][1];
                    u32x4 w; w.x = cvtpk(v0[0], v0[1]); w.y = cvtpk(v0[2], v0[3]); w.z = cvtpk(v1[0], v1[1]); w.w = cvtpk(v1[2], v1[3]);
                    *(u32x4*)(rowp + bj * HALF) = w; } }
    }
};
struct EpiSwiGLU {
    static constexpr bool PERM = true, AFTER_DRAIN = false;
    bf16_t* O; int ldc;
    __device__ __forceinline__ void operator()(const f32x4 (&acc)[2][2][4][2], const Unit& u, int wr, int wc, int fr, int fq) const {
        const int row0 = u.pm * BM + wr * 64 + fr, col0 = u.pn * HALF + wc * 32 + 8 * fq;
#pragma unroll
        for (int ai = 0; ai < 2; ++ai)
#pragma unroll
            for (int m = 0; m < 4; ++m) { bf16_t* rowp = O + (size_t)(row0 + ai * HALF + m * 16) * ldc + col0;
                const f32x4 g0 = acc[ai][0][m][0], g1 = acc[ai][0][m][1], u0 = acc[ai][1][m][0], u1 = acc[ai][1][m][1];
                float r[8];
#pragma unroll
                for (int i = 0; i < 4; ++i) { r[i] = silu_f(g0[i]) * u0[i]; r[4 + i] = silu_f(g1[i]) * u1[i]; }
                u32x4 w; w.x = cvtpk(r[0], r[1]); w.y = cvtpk(r[2], r[3]); w.z = cvtpk(r[4], r[5]); w.w = cvtpk(r[6], r[7]);
                *(u32x4*)rowp = w; }
    }
};
struct EpiResid {
    static constexpr bool PERM = false, AFTER_DRAIN = false;
    const float* base; float* out; int ldc; const float* gate; int gstride; float coef;
    __device__ __forceinline__ void operator()(const f32x4 (&acc)[2][2][4][2], const Unit& u, int wr, int wc, int fr, int fq) const {
        const int row0 = u.pm * BM + wr * 64 + fr, col0 = u.pn * BM + wc * 32 + 4 * fq;
        const float* gp = gate + (size_t)((u.pm * BM >= SEQ) ? 1 : 0) * gstride + col0;
        f32x4 gv[2][2];
#pragma unroll
        for (int bj = 0; bj < 2; ++bj)
#pragma unroll
            for (int n = 0; n < 2; ++n) gv[bj][n] = *(const f32x4*)(gp + bj * HALF + n * 16) * coef;
#pragma unroll
        for (int ai = 0; ai < 2; ++ai)
#pragma unroll
            for (int m = 0; m < 4; ++m) { const size_t off = (size_t)(row0 + ai * HALF + m * 16) * ldc + col0;
#pragma unroll
                for (int bj = 0; bj < 2; ++bj)
#pragma unroll
                    for (int n = 0; n < 2; ++n) { const f32x4 bs = *(const f32x4*)(base + off + bj * HALF + n * 16);
                        *(f32x4*)(out + off + bj * HALF + n * 16) = bs + gv[bj][n] * acc[ai][bj][m][n]; }
                asm volatile("" ::: "memory"); }
    }
};
struct EpiSwiGLU8 {
    typedef i32x4 acc_t;
    static constexpr bool PERM = true, AFTER_DRAIN = false;
    bf16_t* O; int ldc; const float* srow; const float* scol;
    __device__ __forceinline__ void operator()(const i32x4 (&acc)[2][2][4][2], const Unit& u, int wr, int wc, int fr, int fq) const {
        const int row0 = u.pm * BM + wr * 64 + fr, col0 = u.pn * HALF + wc * 32 + 8 * fq;
        float rs[2][4];
#pragma unroll
        for (int ai = 0; ai < 2; ++ai)
#pragma unroll
            for (int m = 0; m < 4; ++m) rs[ai][m] = srow[row0 + ai * HALF + m * 16];
        const float* sp = scol + u.pn * BM + wc * 32 + 8 * fq;
        const f32x4 sg0 = *(const f32x4*)(sp), sg1 = *(const f32x4*)(sp + 4), su0 = *(const f32x4*)(sp + HALF), su1 = *(const f32x4*)(sp + HALF + 4);
#pragma unroll
        for (int ai = 0; ai < 2; ++ai)
#pragma unroll
            for (int m = 0; m < 4; ++m) { bf16_t* rowp = O + (size_t)(row0 + ai * HALF + m * 16) * ldc + col0; const float r_ = rs[ai][m];
                const f32x4 g0 = __builtin_convertvector(acc[ai][0][m][0], f32x4) * (sg0 * r_), g1 = __builtin_convertvector(acc[ai][0][m][1], f32x4) * (sg1 * r_);
                const f32x4 u0 = __builtin_convertvector(acc[ai][1][m][0], f32x4) * (su0 * r_), u1 = __builtin_convertvector(acc[ai][1][m][1], f32x4) * (su1 * r_);
                float r[8];
#pragma unroll
                for (int i = 0; i < 4; ++i) { r[i] = silu_f(g0[i]) * u0[i]; r[4 + i] = silu_f(g1[i]) * u1[i]; }
                u32x4 w; w.x = cvtpk(r[0], r[1]); w.y = cvtpk(r[2], r[3]); w.z = cvtpk(r[4], r[5]); w.w = cvtpk(r[6], r[7]);
                *(u32x4*)rowp = w; }
    }
};
typedef _Float16 h16x8 __attribute__((ext_vector_type(8)));
typedef float f32x8 __attribute__((ext_vector_type(8)));
template <bool BASE_F32, bool HALF_COEF> struct EpiResidH {
    static constexpr bool PERM = true, AFTER_DRAIN = false;
    const void* base; _Float16* out; const float* gate; int ldc, gstride;
    __device__ __forceinline__ void operator()(const f32x4 (&acc)[2][2][4][2], const Unit& u, int wr, int wc, int fr, int fq) const {
        constexpr float coef = HALF_COEF ? 0.5f : 1.0f;
        const int row0 = u.pm * BM + wr * 64 + fr, col0 = u.pn * BM + wc * 32 + 8 * fq;
        const float* gp = gate + (size_t)((u.pm * BM >= SEQ) ? 1 : 0) * gstride + col0;
        f32x4 gv[2][2];
#pragma unroll
        for (int bj = 0; bj < 2; ++bj)
#pragma unroll
            for (int n = 0; n < 2; ++n) gv[bj][n] = *(const f32x4*)(gp + bj * HALF + 4 * n) * coef;
#pragma unroll
        for (int ai = 0; ai < 2; ++ai) {
            f32x4 bb[4][2][2];
#pragma unroll
            for (int m = 0; m < 4; ++m) { const size_t off = (size_t)(row0 + ai * HALF + m * 16) * ldc + col0;
#pragma unroll
                for (int bj = 0; bj < 2; ++bj) {
                    if (BASE_F32) { const float* bp = (const float*)base + off + bj * HALF; bb[m][bj][0] = *(const f32x4*)bp; bb[m][bj][1] = *(const f32x4*)(bp + 4); }
                    else { const h16x8 hb = *(const h16x8*)((const _Float16*)base + off + bj * HALF); const f32x8 fb = __builtin_convertvector(hb, f32x8);
                        bb[m][bj][0] = (f32x4){fb[0], fb[1], fb[2], fb[3]}; bb[m][bj][1] = (f32x4){fb[4], fb[5], fb[6], fb[7]}; } } }
#pragma unroll
            for (int m = 0; m < 4; ++m) { const size_t off = (size_t)(row0 + ai * HALF + m * 16) * ldc + col0;
#pragma unroll
                for (int bj = 0; bj < 2; ++bj) {
                    const f32x4 o0 = bb[m][bj][0] + gv[bj][0] * acc[ai][bj][m][0], o1 = bb[m][bj][1] + gv[bj][1] * acc[ai][bj][m][1];
                    const f32x8 o = {o0[0], o0[1], o0[2], o0[3], o1[0], o1[1], o1[2], o1[3]};
                    *(h16x8*)(out + off + bj * HALF) = __builtin_convertvector(o, h16x8); } }
            asm volatile("" ::: "memory"); }
    }
};
template <class E, class = void> struct AccOf { typedef f32x4 type; };
template <class E> struct AccOf<E, decltype((void)sizeof(typename E::acc_t))> { typedef typename E::acc_t type; };
__device__ __forceinline__ f32x4 mma16(bf16x8 b, bf16x8 a, f32x4 c) { return __builtin_amdgcn_mfma_f32_16x16x32_bf16(b, a, c, 0, 0, 0); }
__device__ __forceinline__ i32x4 mma16(bf16x8 b, bf16x8 a, i32x4 c) { return __builtin_amdgcn_mfma_i32_16x16x64_i8(__builtin_bit_cast(i32x4, b), __builtin_bit_cast(i32x4, a), c, 0, 0, 0); }
template <class Epi, class Sched, bool ALIGN_EPI = false, bool SP2 = false>
__device__ __forceinline__ void gemm_phase(PG8_LAS unsigned char* lds, const Gemm g, const Sched& S, const Epi& E) {
    int tid_ = threadIdx.x; asm volatile("" : "+v"(tid_));
    const int tid = tid_, wid = __builtin_amdgcn_readfirstlane(tid >> 6), lane = tid & 63, wr = wid >> 2, wc = wid & 3, fr = lane & 15, fq = lane >> 4;
    const int K = g.K, nt = K / BK;
    unsigned voffA[2], voffB[2];
#pragma unroll
    for (int i = 0; i < 2; ++i) { int R, C; stage_rc(tid * 16 + i * 8192, R, C); const int Rb = Epi::PERM ? ((R & ~31) + perm32(R & 31)) : R;
        voffA[i] = (unsigned)(R * K + C) * 2u; voffB[i] = (unsigned)(Rb * K + C) * 2u; }
    const size_t kstep = (size_t)(BK * 2);
    const size_t hstep = (size_t)HALF * K * 2;
    const size_t tstep = 2 * hstep;
    const unsigned ldsw = (unsigned)wid * 1024u;
    const int aoff = lds_byte(wr * 64 + fr, fq * 8), boff = lds_byte(wc * 32 + fr, fq * 8);
#define PG8_SA(b, h) (((b) * 2 + (h)) * HTB)
#define PG8_SB(b, h) ((4 + (b) * 2 + (h)) * HTB)
#define PG8_STAGE(bufoff, gbase, voff) do { _Pragma("unroll") for (int _i = 0; _i < 2; ++_i) \
        __builtin_amdgcn_global_load_lds((const unsigned*)((const char*)(gbase) + (voff)[_i]), (PG8_LAS unsigned*)(lds + (bufoff) + ldsw + _i * 8192), 16, 0, 0); } while (0)
#define PG8_LDA(dst, b, h) do { _Pragma("unroll") for (int m = 0; m < 4; ++m) _Pragma("unroll") for (int k = 0; k < 2; ++k) dst[m][k] = *(const PG8_LAS bf16x8*)(lds + PG8_SA(b, h) + aoff + m * 2048 + k * 1024); } while (0)
#define PG8_LDB(dst, b, h) do { _Pragma("unroll") for (int n = 0; n < 2; ++n) _Pragma("unroll") for (int k = 0; k < 2; ++k) dst[n][k] = *(const PG8_LAS bf16x8*)(lds + PG8_SB(b, h) + boff + n * 2048 + k * 1024); } while (0)
#define PG8_MMA(ai, bj, At, Bt) do { __builtin_amdgcn_s_setprio(1); _Pragma("unroll") for (int m = 0; m < 4; ++m) _Pragma("unroll") for (int n = 0; n < 2; ++n) _Pragma("unroll") for (int k = 0; k < 2; ++k) \
        acc[ai][bj][m][n] = mma16(Bt[n][k], At[m][k], acc[ai][bj][m][n]); __builtin_amdgcn_s_setprio(0); } while (0)
#define PG8_WAIT_V(n) asm volatile("s_waitcnt vmcnt(" #n ")" ::: "memory")
#define PG8_WAIT_L(n) asm volatile("s_waitcnt lgkmcnt(" #n ")" ::: "memory")
#define PG8_BAR __builtin_amdgcn_s_barrier()
#define PG8_SCHED __builtin_amdgcn_sched_barrier(0)
    Unit cur, nxt; int ui = 0;
    if (!S.next(0, cur)) return;
    typedef typename AccOf<Epi>::type acc_t;
    acc_t acc[2][2][4][2];
#pragma unroll
    for (int a = 0; a < 2; ++a)
#pragma unroll
        for (int b = 0; b < 2; ++b)
#pragma unroll
            for (int m = 0; m < 4; ++m)
#pragma unroll
                for (int n = 0; n < 2; ++n) acc[a][b][m][n] = acc_t{};
    bf16x8 At[4][2], B0[2][2], B1[2][2];
    const char* cA = (const char*)g.A + (size_t)cur.pm * tstep; const char* cB = (const char*)g.Bt + (size_t)cur.pn * tstep;
    S.a_ready(cur);
    if constexpr (SP2) {
        PG8_STAGE(PG8_SB(0, 0), cB, voffB); PG8_STAGE(PG8_SB(0, 1), cB + hstep, voffB); PG8_STAGE(PG8_SA(0, 0), cA, voffA); PG8_STAGE(PG8_SA(0, 1), cA + hstep, voffA);
        if (wr == 1) PG8_BAR;
        PG8_WAIT_V(2); PG8_BAR;
        PG8_STAGE(PG8_SB(1, 0), cB + kstep, voffB); PG8_STAGE(PG8_SA(1, 0), cA + kstep, voffA); PG8_STAGE(PG8_SB(1, 1), cB + hstep + kstep, voffB);
        PG8_WAIT_V(6); PG8_BAR;
    } else {
        PG8_STAGE(PG8_SB(0, 0), cB, voffB); PG8_STAGE(PG8_SA(0, 0), cA, voffA); PG8_STAGE(PG8_SB(0, 1), cB + hstep, voffB); PG8_STAGE(PG8_SA(0, 1), cA + hstep, voffA);
        if (wr == 1) PG8_BAR;
        PG8_WAIT_V(4); PG8_BAR;
        PG8_STAGE(PG8_SB(1, 0), cB + kstep, voffB); PG8_STAGE(PG8_SA(1, 0), cA + kstep, voffA); PG8_STAGE(PG8_SB(1, 1), cB + hstep + kstep, voffB);
        PG8_WAIT_V(6); PG8_BAR;
    }
    for (;;) {
        const bool has_next = S.next(ui + 1, nxt);
        const char* nA = has_next ? (const char*)g.A + (size_t)nxt.pm * tstep : cA; const char* nB = has_next ? (const char*)g.Bt + (size_t)nxt.pn * tstep : cB;
        for (int t = 0; t < nt; t += 2) {
            const bool last = (t == nt - 2);
            const char* a1 = cA + (size_t)(t + 1) * kstep;
            const char* a2 = last ? nA : cA + (size_t)(t + 2) * kstep; const char* b2 = last ? nB : cB + (size_t)(t + 2) * kstep;
            const char* a3 = a2 + kstep; const char* b3 = b2 + kstep;
            if (last && has_next) S.a_ready(nxt);
            if constexpr (SP2) {
            PG8_LDB(B0, 0, 0); PG8_LDB(B1, 0, 1); PG8_SCHED; PG8_LDA(At, 0, 0); PG8_STAGE(PG8_SA(1, 1), a1 + hstep, voffA);
            PG8_WAIT_V(8); PG8_WAIT_L(0); PG8_BAR; PG8_MMA(0, 0, At, B0); PG8_MMA(0, 1, At, B1); PG8_BAR; PG8_SCHED;
            PG8_LDA(At, 0, 1); PG8_STAGE(PG8_SB(0, 0), b2, voffB); PG8_STAGE(PG8_SB(0, 1), b2 + hstep, voffB); PG8_STAGE(PG8_SA(0, 0), a2, voffA);
            PG8_WAIT_V(8); PG8_WAIT_L(0); PG8_BAR; PG8_MMA(1, 0, At, B0); PG8_MMA(1, 1, At, B1); PG8_BAR; PG8_SCHED;
            PG8_LDB(B0, 1, 0); PG8_LDB(B1, 1, 1); PG8_SCHED; PG8_LDA(At, 1, 0); PG8_STAGE(PG8_SA(0, 1), a2 + hstep, voffA);
            PG8_WAIT_V(8); PG8_WAIT_L(0); PG8_BAR; PG8_MMA(0, 0, At, B0); PG8_MMA(0, 1, At, B1); PG8_BAR; PG8_SCHED;
            PG8_LDA(At, 1, 1); PG8_STAGE(PG8_SB(1, 0), b3, voffB); PG8_STAGE(PG8_SB(1, 1), b3 + hstep, voffB); PG8_STAGE(PG8_SA(1, 0), a3, voffA);
            PG8_WAIT_V(8); PG8_WAIT_L(0); PG8_BAR; PG8_MMA(1, 0, At, B0); PG8_MMA(1, 1, At, B1); PG8_BAR; PG8_SCHED;
            } else {
            PG8_LDB(B0, 0, 0); PG8_SCHED; PG8_LDA(At, 0, 0); PG8_STAGE(PG8_SA(1, 1), a1 + hstep, voffA);
            PG8_WAIT_L(8); PG8_BAR; PG8_WAIT_L(0); PG8_MMA(0, 0, At, B0); PG8_BAR; PG8_SCHED;
            PG8_LDB(B1, 0, 1); PG8_STAGE(PG8_SB(0, 0), b2, voffB);
            PG8_BAR; PG8_WAIT_L(0); PG8_MMA(0, 1, At, B1); PG8_BAR;
            PG8_LDA(At, 0, 1); PG8_STAGE(PG8_SA(0, 0), a2, voffA);
            PG8_BAR; PG8_WAIT_L(0); PG8_MMA(1, 0, At, B0); PG8_BAR; PG8_SCHED;
            PG8_STAGE(PG8_SB(0, 1), b2 + hstep, voffB);
            PG8_WAIT_V(6); PG8_BAR; PG8_MMA(1, 1, At, B1); PG8_BAR;
            PG8_LDB(B0, 1, 0); PG8_SCHED; PG8_LDA(At, 1, 0); PG8_STAGE(PG8_SA(0, 1), a2 + hstep, voffA);
            PG8_WAIT_L(8); PG8_BAR; PG8_WAIT_L(0); PG8_MMA(0, 0, At, B0); PG8_BAR; PG8_SCHED;
            PG8_LDB(B1, 1, 1); PG8_STAGE(PG8_SB(1, 0), b3, voffB);
            PG8_BAR; PG8_WAIT_L(0); PG8_MMA(0, 1, At, B1); PG8_BAR;
            PG8_LDA(At, 1, 1); PG8_STAGE(PG8_SA(1, 0), a3, voffA);
            PG8_BAR; PG8_WAIT_L(0); PG8_MMA(1, 0, At, B0); PG8_BAR; PG8_SCHED;
            PG8_STAGE(PG8_SB(1, 1), b3 + hstep, voffB);
            PG8_WAIT_V(6); PG8_BAR; PG8_MMA(1, 1, At, B1); PG8_BAR;
            }
        }
        if constexpr (ALIGN_EPI) { if (wr == 0) PG8_BAR; }
        if constexpr (!Epi::AFTER_DRAIN) { E(acc, cur, wr, wc, fr, fq); S.done(cur); }
        if (!has_next) break;
#pragma unroll
        for (int a = 0; a < 2; ++a)
#pragma unroll
            for (int b = 0; b < 2; ++b)
#pragma unroll
                for (int m = 0; m < 4; ++m)
#pragma unroll
                    for (int n = 0; n < 2; ++n) acc[a][b][m][n] = acc_t{};
        cur = nxt; cA = nA; cB = nB; ++ui;
        if constexpr (ALIGN_EPI) { if (wr == 1) PG8_BAR; }
    }
    PG8_WAIT_V(0);
    if constexpr (!ALIGN_EPI) { if (wr == 0) PG8_BAR; }
    PG8_BAR;
    if constexpr (Epi::AFTER_DRAIN) { E.fused(acc, cur, wr, wc, fr, fq, lds, wid, lane); S.done(cur); }
#undef PG8_SA
#undef PG8_SB
#undef PG8_STAGE
#undef PG8_LDA
#undef PG8_LDB
#undef PG8_MMA
#undef PG8_WAIT_V
#undef PG8_WAIT_L
#undef PG8_BAR
#undef PG8_SCHED
}
}

#ifndef GEMM_SP2
#define GEMM_SP2 true
#endif
#ifndef GEMM_ALIGN
#define GEMM_ALIGN true
#endif
#ifndef DN_ORDER
#define DN_ORDER pg8::StaticOrderRev
#endif
constexpr int NWAVES = 8;
#ifndef MK_N_LAUNCHES
#define MK_N_LAUNCHES 1
#endif
constexpr int NPH = 2 + 12 * DEPTH;

constexpr size_t MiB = 1u << 20;
constexpr size_t WS_CTL = 0, CTL_ZERO_BYTES = 1 * MiB;
constexpr size_t WS_MOD = 1 * MiB;
constexpr size_t WS_FMOD = WS_MOD + (size_t)DEPTH * BATCH * NMOD * D * 4;
constexpr size_t WS_W = 2 * MiB, W_LAYER = 158 * MiB, W_FFN = 66 * MiB, W_DN = 44 * MiB, W_IN = 132 * MiB, W_OUT = 150 * MiB;
constexpr size_t WS_U = 640 * MiB;
constexpr size_t WS_HID = 768 * MiB;
constexpr size_t WS_OMIX = 1120 * MiB;
constexpr size_t WS_KVT = 1248 * MiB;
constexpr size_t WS_ST = 1504 * MiB;
constexpr size_t WS_DEC = 1632 * MiB;
constexpr size_t WS_H = 1634 * MiB;
constexpr size_t WS_TOK0 = 1762 * MiB;
constexpr size_t WS_SROW = 1763 * MiB;
constexpr size_t WS_SCOL = 1764 * MiB;
constexpr size_t WS_END = 1765 * MiB;
static_assert(WS_FMOD + (size_t)BATCH * 2 * D * 4 <= WS_W, "mod fits");
static_assert((size_t)NUP * D * 2 == 44 * MiB && (size_t)D * FF * 2 == 22 * MiB && (size_t)NIN * D * 2 == 18 * MiB && (size_t)D * D * 2 == 8 * MiB, "weight sizes");
static_assert(WS_W + DEPTH * W_LAYER <= WS_U && (size_t)M * D * 2 == 128 * MiB && (size_t)M * FF * 2 == 352 * MiB && (size_t)M * NIN * 2 <= 352 * MiB, "ws map");
constexpr int CW_TMO = 0, CW_CODE = 1;
constexpr int CW_BAR = 4096;

constexpr int RING_OFF = 0, RING_BYTES = 131072;
constexpr int LDSCTL_OFF = RING_BYTES, MISC_OFF = LDSCTL_OFF + 320;
constexpr int LDS_BYTES = 147456;
static_assert(MISC_OFF + 128 <= LDS_BYTES, "LDS map");

#define GAS __attribute__((address_space(1)))
#define LAS __attribute__((address_space(3)))
typedef unsigned short bf16;
typedef unsigned v4u __attribute__((ext_vector_type(4)));
typedef unsigned v2u __attribute__((ext_vector_type(2)));
typedef float f32x2 __attribute__((ext_vector_type(2)));
typedef float f32x4 __attribute__((ext_vector_type(4)));
typedef float f32x16 __attribute__((ext_vector_type(16)));
typedef short bf16x8 __attribute__((ext_vector_type(8)));
typedef short s16x4 __attribute__((ext_vector_type(4)));
typedef GAS unsigned gu32;
#define RLX_AGENT __ATOMIC_RELAXED, __HIP_MEMORY_SCOPE_AGENT
#define LDS_WAIT() asm volatile("s_waitcnt lgkmcnt(0)" ::: "memory")
#define VM_WAIT() asm volatile("s_waitcnt vmcnt(0)" ::: "memory")
#define MFMA32(a, b, c) __builtin_amdgcn_mfma_f32_32x32x16_bf16((a), (b), (c), 0, 0, 0)
__device__ __forceinline__ unsigned f2bf(float f) { unsigned u = __builtin_bit_cast(unsigned, f); return (u + 0x7fffu + ((u >> 16) & 1u)) >> 16; }
__device__ __forceinline__ unsigned pk2(float lo, float hi) { return pg8::cvtpk(lo, hi); }
__device__ __forceinline__ float bf2f(unsigned b) { return __builtin_bit_cast(float, b << 16); }
__device__ __forceinline__ int crow(int r, int hi) { return (r & 3) + 8 * (r >> 2) + 4 * hi; }
__device__ __forceinline__ bf16x8 pack8(const f32x16& x, int s, float sc) {
    v4u p; p.x = pk2(x[8 * s + 0] * sc, x[8 * s + 1] * sc); p.y = pk2(x[8 * s + 2] * sc, x[8 * s + 3] * sc); p.z = pk2(x[8 * s + 4] * sc, x[8 * s + 5] * sc); p.w = pk2(x[8 * s + 6] * sc, x[8 * s + 7] * sc);
    return __builtin_bit_cast(bf16x8, p);
}
__device__ __forceinline__ float shx(float v, int o, int lane) { return __builtin_bit_cast(float, __builtin_amdgcn_ds_bpermute((lane ^ o) << 2, __builtin_bit_cast(int, v))); }
__device__ __forceinline__ float wave_max(float v, int lane) {
#pragma unroll
    for (int o = 1; o < 64; o <<= 1) v = fmaxf(v, shx(v, o, lane));
    return v;
}
__device__ __forceinline__ unsigned q8x4(f32x4 y, float inv) {
    const int a = (int)__builtin_rintf(y.x * inv), b = (int)__builtin_rintf(y.y * inv), c = (int)__builtin_rintf(y.z * inv), d = (int)__builtin_rintf(y.w * inv);
    return (unsigned)(a & 0xff) | ((unsigned)(b & 0xff) << 8) | ((unsigned)(c & 0xff) << 16) | ((unsigned)(d & 0xff) << 24);
}
__device__ __forceinline__ float wave_sum(float v, int lane) {
#pragma unroll
    for (int o = 1; o < 64; o <<= 1) v += shx(v, o, lane);
    return v;
}
#define XB_TMO      128
#define XB_XCNT(j)  (256  + 64 * (j))
#define XB_XSUB(j)  (1280 + 64 * (j))
#define XB_XGEN(j)  (2304 + 64 * (j))
#define XB_TOP      3328
#define XB_TOPGEN   3392
#define XCD_BAR_WORDS 3456
#define XB_SPIN_CAP (1u << 18)

__device__ __forceinline__ unsigned xb_ld(unsigned* p)              { return __hip_atomic_load(p, __ATOMIC_RELAXED, __HIP_MEMORY_SCOPE_AGENT); }
__device__ __forceinline__ unsigned xb_add(unsigned* p, unsigned v) { return __hip_atomic_fetch_add(p, v, __ATOMIC_RELAXED, __HIP_MEMORY_SCOPE_AGENT); }
__device__ __forceinline__ unsigned xb_xcc_id() { return (unsigned)__builtin_amdgcn_s_getreg((3 << 11) | 20) & 0xFu; }
#define XB_SPIN(cond, bar) do { unsigned _sp = 0; while (cond) { __builtin_amdgcn_s_sleep(1); \
    if ((++_sp & 255u) == 0u) { if (xb_ld(&(bar)[XB_TMO])) break; if (_sp > XB_SPIN_CAP) { atomicAdd(&(bar)[XB_TMO], 1u); break; } } } } while (0)

struct XcdBarrier {
    unsigned* bar; unsigned x;
    volatile LAS unsigned* st;
};

__device__ __forceinline__ XcdBarrier xcd_barrier_post(unsigned* bar, volatile LAS unsigned* st) {
    XcdBarrier b; b.bar = bar; b.x = xb_xcc_id(); b.st = st;
    if (threadIdx.x == 0) (void)xb_add(&bar[XB_XCNT(b.x)], 1u);
    return b;
}
__device__ __forceinline__ void xcd_barrier_complete(unsigned* bar, unsigned x, unsigned& nloc, unsigned& nx) {
    const unsigned G = gridDim.x * gridDim.y * gridDim.z;
    unsigned sum, cnt, mine, sp = 0u;
    for (;;) {
        sum = 0u; cnt = 0u; mine = 0u;
#pragma unroll
        for (unsigned j = 0; j < 16; ++j) { const unsigned c = xb_ld(&bar[XB_XCNT(j)]); sum += c; cnt += (c > 0u) ? 1u : 0u; mine = (j == x) ? c : mine; }
        if (sum == G) break;
        __builtin_amdgcn_s_sleep(1);
        if ((++sp & 255u) == 0u) { if (xb_ld(&bar[XB_TMO])) break; if (sp > XB_SPIN_CAP) { atomicAdd(&bar[XB_TMO], 1u); break; } }
    }
    nloc = mine > 0u ? mine : 1u; nx = cnt > 0u ? cnt : 1u;
}

__device__ __forceinline__ void xcd_barrier(const XcdBarrier& b) {
    asm volatile("s_waitcnt vmcnt(0)" ::: "memory");
    __syncthreads();
    if (threadIdx.x == 0) {
        unsigned* bar = b.bar;
#ifdef PROBE_WAIT
        const unsigned long long t0_ = wall_clock64();
        const unsigned rnd_ = b.st[6]; b.st[6] = rnd_ + 1u;
        atomicMax(&bar[4204 + rnd_], (unsigned)t0_);
#endif
        __builtin_amdgcn_s_waitcnt(0);
        unsigned nloc = b.st[0], nx = b.st[1];
        if (nloc == 0u) { xcd_barrier_complete(bar, b.x, nloc, nx); b.st[0] = nloc; b.st[1] = nx; }
#ifdef EARLY_WB
        __builtin_amdgcn_fence(__ATOMIC_RELEASE, "agent");
        asm volatile("s_waitcnt vmcnt(0)" ::: "memory");
#endif
        const unsigned old = xb_add(&bar[XB_XSUB(b.x)], 1u);
        const unsigned gen = old / nloc;
        if (old + 1u == (gen + 1u) * nloc) {
#ifdef PROBE_WAIT
            const unsigned long long t1_ = wall_clock64();
#endif
            __builtin_amdgcn_fence(__ATOMIC_RELEASE, "agent");
            asm volatile("s_waitcnt vmcnt(0)" ::: "memory");
#ifdef PROBE_WAIT
            b.st[5] += (unsigned)(wall_clock64() - t1_);
#endif
            const unsigned og = xb_add(&bar[XB_TOP], 1u);
            const unsigned tg = og / nx;
            if (og + 1u == (tg + 1u) * nx) xb_add(&bar[XB_TOPGEN], 1u);
            else XB_SPIN(xb_ld(&bar[XB_TOPGEN]) == tg, bar);
            __builtin_amdgcn_fence(__ATOMIC_ACQUIRE, "agent");
#ifndef BAR_FLAT
            xb_add(&bar[XB_XGEN(b.x)], 1u);
#endif
            asm volatile("s_waitcnt vmcnt(0)" ::: "memory");
        } else {
#ifdef BAR_FLAT
            XB_SPIN(xb_ld(&bar[XB_TOPGEN]) == gen, bar);
#else
            XB_SPIN(xb_ld(&bar[XB_XGEN(b.x)]) == gen, bar);
#endif
            __builtin_amdgcn_fence(__ATOMIC_ACQUIRE, "agent");
            asm volatile("s_waitcnt vmcnt(0)" ::: "memory");
        }
#ifdef PROBE_WAIT
        { const unsigned long long t2_ = wall_clock64(); { const int q_ = rnd_ >= 2u ? (int)((rnd_ - 2u) % 12u) : 12; if ((PROBE_QMASK >> q_) & 1) b.st[4] += (unsigned)(t2_ - t0_); } if (blockIdx.x == 0) b.st[7] += (unsigned)t2_ - xb_ld(&bar[4204 + rnd_]); }
#endif
    }
    __syncthreads();
}

struct Args { const float* in[22]; float* out; unsigned char* ws; int ph_lo, ph_hi, li, pad; };
struct Ctx {
    LAS unsigned char* lds;
    int tid, lane, wave, G, gw, NGW;
};
enum { I_X = 0, I_C, I_ADAW, I_ADAB, I_NFFN1, I_F1W1, I_F1W3, I_F1W2, I_NMIX, I_WIN, I_GW2, I_GB, I_SINK, I_GNORM, I_WOUT, I_NFFN2, I_F2W1, I_F2W3, I_F2W2, I_FADAW, I_FADAB, I_FNORM };

__device__ __forceinline__ void p0_mod(const Ctx& C, const Args& a) {
    LAS float* cact = (LAS float*)C.lds;
    LAS float* red = (LAS float*)(C.lds + 16384);
    for (int i = C.tid; i < BATCH * D; i += NWAVES * 64) { const float c = a.in[I_C][i]; cact[i] = c / (1.0f + expf(-c)); }
    __syncthreads();
    float* modp = (float*)(a.ws + WS_MOD); float* fmodp = (float*)(a.ws + WS_FMOD);
    constexpr int IT_L = NMOD * D / 256, NITEM = DEPTH * IT_L + 2 * D / 256;
    for (int it = blockIdx.x; it < NITEM; it += C.G) {
        const float* W; const float* bias; float* o0; int N, c0;
        if (it < DEPTH * IT_L) { const int l = it / IT_L; c0 = (it % IT_L) * 256; N = NMOD * D; W = a.in[I_ADAW] + (size_t)l * D * N; bias = a.in[I_ADAB] + (size_t)l * N; o0 = modp + (size_t)l * BATCH * N; }
        else { c0 = (it - DEPTH * IT_L) * 256; N = 2 * D; W = a.in[I_FADAW]; bias = a.in[I_FADAB]; o0 = fmodp; }
        f32x4 a0 = {0.f, 0.f, 0.f, 0.f}, a1 = {0.f, 0.f, 0.f, 0.f};
        const int kb = 256 * C.wave;
        const float* wp = W + (size_t)kb * N + c0 + 4 * C.lane;
#pragma unroll 8
        for (int k = 0; k < 256; ++k) { const f32x4 w = *(const f32x4*)(wp + (size_t)k * N); const float x0 = cact[kb + k], x1 = cact[D + kb + k]; a0 += w * x0; a1 += w * x1; }
#pragma unroll
        for (int j = 0; j < 4; ++j) { red[(C.wave * 2 + 0) * 256 + 4 * C.lane + j] = a0[j]; red[(C.wave * 2 + 1) * 256 + 4 * C.lane + j] = a1[j]; }
        __syncthreads();
        { const int b = C.tid >> 8, col = C.tid & 255; float s = 0.f;
#pragma unroll
          for (int w = 0; w < 8; ++w) s += red[(w * 2 + b) * 256 + col];
          o0[(size_t)b * N + c0 + col] = s + bias[c0 + col]; }
        __syncthreads();
    }
}
__device__ __forceinline__ void p0_transpose_item(const float* W, int K, int N, int nvalid, bf16* dst, LAS float* scr, int k0, int n0, int lane) {
    const int col = n0 + (lane & 31); const bool ok = col < nvalid;
    const float* src = W + (size_t)(k0 + (lane >> 5)) * N + (ok ? col : 0);
    float t[32];
#pragma unroll
    for (int i = 0; i < 32; ++i) t[i] = src[(size_t)(2 * i) * N];
#pragma unroll
    for (int i = 0; i < 32; ++i) scr[(2 * i + (lane >> 5)) * 33 + (lane & 31)] = ok ? t[i] : 0.f;
    LDS_WAIT(); asm volatile("" ::: "memory");
    const int c = lane & 7;
#pragma unroll
    for (int j = 0; j < 4; ++j) { const int n = (lane >> 3) + 8 * j; const LAS float* s = scr + (8 * c) * 33 + n;
        v4u o; o.x = pk2(s[0 * 33], s[1 * 33]); o.y = pk2(s[2 * 33], s[3 * 33]); o.z = pk2(s[4 * 33], s[5 * 33]); o.w = pk2(s[6 * 33], s[7 * 33]);
        *(GAS v4u*)(dst + (size_t)n * K + k0 + 8 * c) = o; }
    LDS_WAIT(); asm volatile("" ::: "memory");
}
__device__ __forceinline__ void p0_transpose_item_i8(const float* W, int N, int K8, signed char* dst8, const LAS float* cmax, float* sc, LAS float* scr, int k0, int n0, int lane) {
    const float* src = W + (size_t)(k0 + (lane >> 5)) * N + n0 + (lane & 31);
    float t[32];
#pragma unroll
    for (int i = 0; i < 32; ++i) t[i] = src[(size_t)(2 * i) * N];
#pragma unroll
    for (int i = 0; i < 32; ++i) scr[(2 * i + (lane >> 5)) * 33 + (lane & 31)] = t[i];
    LDS_WAIT(); asm volatile("" ::: "memory");
    const int c = lane & 7;
#pragma unroll
    for (int j = 0; j < 4; ++j) { const int n = (lane >> 3) + 8 * j; const LAS float* p = scr + (8 * c) * 33 + n;
        const float sv = cmax[n] * (1.0f / 127.0f), inv = sv > 0.f ? 1.0f / sv : 0.f;
        if (k0 == 0 && c == 0) sc[n] = sv;
        v2u o; o.x = q8x4((f32x4){p[0 * 33], p[1 * 33], p[2 * 33], p[3 * 33]}, inv); o.y = q8x4((f32x4){p[4 * 33], p[5 * 33], p[6 * 33], p[7 * 33]}, inv);
        *(GAS v2u*)(dst8 + (size_t)n * K8 + k0 + 8 * c) = o; }
    LDS_WAIT(); asm volatile("" ::: "memory");
}
constexpr int P0_I_UP = (D / 64) * (FF / 32), P0_I_DN = (FF / 64) * (D / 32), P0_I_IN = (D / 64) * (NIN / 32), P0_I_OUT = (D / 64) * (D / 32);
constexpr int P0_NCV0 = DEPTH * (2 * P0_I_DN + P0_I_IN + P0_I_OUT);
constexpr int P0_NUPT = DEPTH * 4 * (FF / 32);
__device__ __forceinline__ void p0_up_task(const Ctx& C, const Args& a, LAS float* scr, LAS float* cm, int it) {
    constexpr int NB = FF / 32;
    const int l = it / (4 * NB); int r = it % (4 * NB); const int f = r / (2 * NB); r %= 2 * NB; const int which = r / NB, nb = r % NB;
    const float* W = a.in[f ? (which ? I_F2W3 : I_F2W1) : (which ? I_F1W3 : I_F1W1)] + (size_t)l * D * FF;
    { const float* src = W + (size_t)(256 * C.wave + (C.lane >> 5)) * FF + 32 * nb + (C.lane & 31);
      float mx = 0.f;
#pragma unroll 16
      for (int i = 0; i < 128; ++i) mx = fmaxf(mx, fabsf(src[(size_t)(2 * i) * FF]));
      mx = fmaxf(mx, shx(mx, 32, C.lane));
      if (C.lane < 32) cm[C.wave * 32 + C.lane] = mx; }
    __syncthreads();
    if (C.tid < 32) { float m = cm[C.tid];
#pragma unroll
        for (int w = 1; w < NWAVES; ++w) m = fmaxf(m, cm[w * 32 + C.tid]);
        cm[NWAVES * 32 + C.tid] = m; }
    __syncthreads();
    unsigned char* wl = a.ws + WS_W + (size_t)l * W_LAYER;
    const int jr = (nb >> 2) * 256 + (nb & 3) * 32 + which * 128;
    const size_t so = (size_t)(l * 2 + f) * NUP + jr;
#pragma unroll 1
    for (int q = 0; q < 4; ++q)
        p0_transpose_item_i8(W, FF, D, (signed char*)(wl + f * W_FFN) + (size_t)jr * D, cm + NWAVES * 32, (float*)(a.ws + WS_SCOL) + so, scr, 64 * (4 * C.wave + q), 32 * nb, C.lane);
    __syncthreads();
}
__device__ __forceinline__ void p0_conv0_item(const Args& a, LAS float* scr, int it, int lane) {
    constexpr int PER_L = 2 * P0_I_DN + P0_I_IN + P0_I_OUT;
    const int l = it / PER_L; int r = it % PER_L;
    unsigned char* wl = a.ws + WS_W + (size_t)l * W_LAYER;
    if (r < 2 * P0_I_DN) { const int f = r / P0_I_DN; r %= P0_I_DN; const int kb = r / (D / 32), nb = r % (D / 32);
        const float* W = a.in[f ? I_F2W2 : I_F1W2] + (size_t)l * FF * D;
        p0_transpose_item(W, FF, D, D, (bf16*)(wl + f * W_FFN + W_DN) + (size_t)(32 * nb) * FF, scr, 64 * kb, 32 * nb, lane); }
    else { r -= 2 * P0_I_DN;
        if (r < P0_I_IN) { const int kb = r / (NIN / 32), nb = r % (NIN / 32);
            p0_transpose_item(a.in[I_WIN] + (size_t)l * D * NINR, D, NINR, NINR, (bf16*)(wl + W_IN) + (size_t)(32 * nb) * D, scr, 64 * kb, 32 * nb, lane); }
        else { r -= P0_I_IN; const int kb = r / (D / 32), nb = r % (D / 32);
            p0_transpose_item(a.in[I_WOUT] + (size_t)l * D * D, D, D, D, (bf16*)(wl + W_OUT) + (size_t)(32 * nb) * D, scr, 64 * kb, 32 * nb, lane); } }
}
constexpr int P0_MOD_ITEMS = DEPTH * (NMOD * D / 256) + 2 * D / 256;
#ifndef P0_CV_LO
#define P0_CV_LO 159
#define P0_CV_HI 308
#endif
__device__ __forceinline__ unsigned wg_draw(volatile LAS unsigned* q, int lane) {
    unsigned v = 0u; if (lane == 0) v = __hip_atomic_fetch_add((LAS unsigned*)q, 1u, __ATOMIC_RELAXED, __HIP_MEMORY_SCOPE_WORKGROUP);
    return (unsigned)__builtin_amdgcn_readfirstlane((int)v);
}
__device__ __forceinline__ void p0_phase_a(const Ctx& C, const Args& a, volatile LAS unsigned* q) {
    LAS float* scr = (LAS float*)(C.lds + 32768 + C.wave * 8704);
    LAS float* cm = (LAS float*)(C.lds + 32768 + NWAVES * 8704);
    const int w = blockIdx.x, G = C.G;
    int c0, cn;
    if (G == 256) { const int extra = P0_MOD_ITEMS - 256; c0 = w < extra ? P0_CV_LO * w : P0_CV_LO * extra + P0_CV_HI * (w - extra); cn = w < extra ? P0_CV_LO : P0_CV_HI; }
    else { c0 = (int)((long long)P0_NCV0 * w / G); cn = (int)((long long)P0_NCV0 * (w + 1) / G) - c0; }
    if (c0 > P0_NCV0) c0 = P0_NCV0;
    if (c0 + cn > P0_NCV0) cn = P0_NCV0 - c0;
    if (G == 256 && w == G - 1) cn = P0_NCV0 - c0;
    const int m0 = (int)((long long)P0_NUPT * w / G), m1 = (int)((long long)P0_NUPT * (w + 1) / G);
#pragma unroll 1
    for (int t = m0; t < m1; ++t) p0_up_task(C, a, scr, cm, t);
    for (;;) { const unsigned i = wg_draw(q, C.lane); if (i >= (unsigned)cn) break; p0_conv0_item(a, scr, c0 + (int)i, C.lane); }
}

template <bool FINAL>
__device__ __forceinline__ void norm_phase(const Ctx& C, const float* src, const float* w, const float* shv, const float* scv, int bstride, bf16* u, float* outf) {
    int cur_b = -1; f32x4 A[8], B[8];
#pragma unroll
    for (int j = 0; j < 8; ++j) { A[j] = (f32x4){0.f, 0.f, 0.f, 0.f}; B[j] = A[j]; }
    for (int m = C.gw; m < M; m += C.NGW) {
        const int b = m >= SEQ ? 1 : 0;
        if (b != cur_b) { cur_b = b;
#pragma unroll
            for (int j = 0; j < 8; ++j) { const int col = 4 * (C.lane + 64 * j); const f32x4 wv = *(const f32x4*)(w + col), sc = *(const f32x4*)(scv + (size_t)b * bstride + col); A[j] = wv * (sc + 1.0f); B[j] = *(const f32x4*)(shv + (size_t)b * bstride + col); } }
        const f32x4* xr = (const f32x4*)(src + (size_t)m * D) + C.lane;
        f32x4 v[8]; float s = 0.f;
#pragma unroll
        for (int j = 0; j < 8; ++j) v[j] = xr[64 * j];
#pragma unroll
        for (int j = 0; j < 8; ++j) s += (v[j].x * v[j].x + v[j].y * v[j].y) + (v[j].z * v[j].z + v[j].w * v[j].w);
        const float r = 1.0f / sqrtf(wave_sum(s, C.lane) * (1.0f / D) + EPS);
#pragma unroll
        for (int j = 0; j < 8; ++j) { const f32x4 y = v[j] * r * A[j] + B[j];
            if (FINAL) ((f32x4*)(outf + (size_t)m * D))[C.lane + 64 * j] = y;
            else { v2u o; o.x = pk2(y.x, y.y); o.y = pk2(y.z, y.w); ((v2u*)(u + (size_t)m * D))[C.lane + 64 * j] = o; } }
    }
}

typedef _Float16 h16x8n __attribute__((ext_vector_type(8)));
typedef float f32x8n __attribute__((ext_vector_type(8)));
template <bool FINAL>
__device__ __forceinline__ void norm_phase_h(const Ctx& C, const _Float16* src, const float* w, const float* shv, const float* scv, int bstride, bf16* u, float* outf) {
    int cur_b = -1; f32x4 A[8], B[8];
#pragma unroll
    for (int j = 0; j < 8; ++j) { A[j] = (f32x4){0.f, 0.f, 0.f, 0.f}; B[j] = A[j]; }
    for (int m = C.gw; m < M; m += C.NGW) {
        const int b = m >= SEQ ? 1 : 0;
        if (b != cur_b) { cur_b = b;
#pragma unroll
            for (int j = 0; j < 8; ++j) { const int col = 8 * (C.lane + 64 * (j >> 1)) + 4 * (j & 1); const f32x4 wv = *(const f32x4*)(w + col), sc = *(const f32x4*)(scv + (size_t)b * bstride + col); A[j] = wv * (sc + 1.0f); B[j] = *(const f32x4*)(shv + (size_t)b * bstride + col); } }
        const h16x8n* xr = (const h16x8n*)(src + (size_t)m * D) + C.lane;
        h16x8n q[4]; f32x4 v[8]; float s = 0.f;
#pragma unroll
        for (int j = 0; j < 4; ++j) q[j] = xr[64 * j];
#pragma unroll
        for (int j = 0; j < 4; ++j) { const f32x8n f = __builtin_convertvector(q[j], f32x8n); v[2 * j] = (f32x4){f[0], f[1], f[2], f[3]}; v[2 * j + 1] = (f32x4){f[4], f[5], f[6], f[7]}; }
#pragma unroll
        for (int j = 0; j < 8; ++j) s += (v[j].x * v[j].x + v[j].y * v[j].y) + (v[j].z * v[j].z + v[j].w * v[j].w);
        const float r = 1.0f / sqrtf(wave_sum(s, C.lane) * (1.0f / D) + EPS);
#pragma unroll
        for (int j = 0; j < 4; ++j) { const f32x4 y0 = v[2 * j] * r * A[2 * j] + B[2 * j], y1 = v[2 * j + 1] * r * A[2 * j + 1] + B[2 * j + 1];
            if (FINAL) { f32x4* o = (f32x4*)(outf + (size_t)m * D + 8 * (C.lane + 64 * j)); o[0] = y0; o[1] = y1; }
            else { v4u o; o.x = pk2(y0.x, y0.y); o.y = pk2(y0.z, y0.w); o.z = pk2(y1.x, y1.y); o.w = pk2(y1.z, y1.w); ((v4u*)(u + (size_t)m * D))[C.lane + 64 * j] = o; } }
    }
}

template <bool SRC_F32>
__device__ __forceinline__ void norm_q8(const Ctx& C, const void* src, const float* w, const float* shv, const float* scv, int bstride, signed char* u8, float* srow) {
    int cur_b = -1; f32x4 A[8], B[8];
#pragma unroll
    for (int j = 0; j < 8; ++j) { A[j] = (f32x4){0.f, 0.f, 0.f, 0.f}; B[j] = A[j]; }
    for (int m = C.gw; m < M; m += C.NGW) {
        const int b = m >= SEQ ? 1 : 0;
        if (b != cur_b) { cur_b = b;
#pragma unroll
            for (int j = 0; j < 8; ++j) { const int col = 8 * (C.lane + 64 * (j >> 1)) + 4 * (j & 1); const f32x4 wv = *(const f32x4*)(w + col), sc = *(const f32x4*)(scv + (size_t)b * bstride + col); A[j] = wv * (sc + 1.0f); B[j] = *(const f32x4*)(shv + (size_t)b * bstride + col); } }
        f32x4 v[8]; float s = 0.f;
        if (SRC_F32) { const f32x4* xr = (const f32x4*)((const float*)src + (size_t)m * D);
#pragma unroll
            for (int j = 0; j < 8; ++j) v[j] = xr[2 * (C.lane + 64 * (j >> 1)) + (j & 1)]; }
        else { const h16x8n* xr = (const h16x8n*)((const _Float16*)src + (size_t)m * D) + C.lane;
#pragma unroll
            for (int j = 0; j < 4; ++j) { const f32x8n f = __builtin_convertvector(xr[64 * j], f32x8n); v[2 * j] = (f32x4){f[0], f[1], f[2], f[3]}; v[2 * j + 1] = (f32x4){f[4], f[5], f[6], f[7]}; } }
#pragma unroll
        for (int j = 0; j < 8; ++j) s += (v[j].x * v[j].x + v[j].y * v[j].y) + (v[j].z * v[j].z + v[j].w * v[j].w);
        const float r = 1.0f / sqrtf(wave_sum(s, C.lane) * (1.0f / D) + EPS);
        float am = 0.f;
#pragma unroll
        for (int j = 0; j < 8; ++j) { v[j] = v[j] * r * A[j] + B[j]; am = fmaxf(am, fmaxf(fmaxf(fabsf(v[j].x), fabsf(v[j].y)), fmaxf(fabsf(v[j].z), fabsf(v[j].w)))); }
        am = wave_max(am, C.lane);
        const float inv = am > 0.f ? 127.0f / am : 0.f;
        if (C.lane == 0) srow[m] = am * (1.0f / 127.0f);
#pragma unroll
        for (int j = 0; j < 4; ++j) { v2u o; o.x = q8x4(v[2 * j], inv); o.y = q8x4(v[2 * j + 1], inv); ((v2u*)(u8 + (size_t)m * D))[C.lane + 64 * j] = o; }
    }
}

constexpr int AT_KROW = 144, AT_VROW = 520, AT_K_OFF = 0, AT_V_OFF = 256 * AT_KROW;
__device__ __forceinline__ void attn_unit(const Ctx& C, const bf16* __restrict__ P, bf16* __restrict__ O, const float* sinks, int unit) {
    const int kv = unit & 1, n = (unit >> 1) & (NBLK - 1), b = unit >> 8;
    const int tb = b * SEQ + n * BLK;
    LAS unsigned char* KL = C.lds + AT_K_OFF; LAS unsigned char* VL = C.lds + AT_V_OFF;
#pragma unroll
    for (int j = 0; j < 4; ++j) { const int idx = C.tid + 512 * j, key = idx >> 3, part = idx & 7;
        v4u kq = {0u, 0u, 0u, 0u}, vq = {0u, 0u, 0u, 0u};
        if (n > 0 || key >= BLK) { const bf16* row = P + (size_t)(tb + key - BLK) * NIN; kq = *(const v4u*)(row + PC_KA + kv * HD + 8 * part); vq = *(const v4u*)(row + PC_VA + kv * HD + 8 * part); }
        *(LAS v4u*)(KL + key * AT_KROW + part * 16) = kq;
        const unsigned vv[4] = {vq.x, vq.y, vq.z, vq.w};
#pragma unroll
        for (int q = 0; q < 4; ++q) { *(LAS unsigned short*)(VL + (8 * part + 2 * q) * AT_VROW + key * 2) = (unsigned short)(vv[q] & 0xffffu); *(LAS unsigned short*)(VL + (8 * part + 2 * q + 1) * AT_VROW + key * 2) = (unsigned short)(vv[q] >> 16); } }
    __syncthreads();
    const int r = C.lane & 31, h = C.lane >> 5, head = kv * GQA + C.wave;
    const float slope = exp2f(-0.5f * (float)(head + 1)), sink = sinks[head];
#pragma unroll 1
    for (int qb = 0; qb < 4; ++qb) {
        bf16x8 qf[4];
        { const bf16* qrow = P + (size_t)(tb + 32 * qb + r) * NIN + PC_QA + head * HD + 8 * h;
#pragma unroll
          for (int s = 0; s < 4; ++s) qf[s] = *(const bf16x8*)(qrow + 16 * s); }
        f32x16 sa[5];
#pragma unroll
        for (int k5 = 0; k5 < 5; ++k5) {
#pragma unroll
            for (int i = 0; i < 16; ++i) sa[k5][i] = 0.f;
#pragma unroll
            for (int s = 0; s < 4; ++s) { const bf16x8 kf = *(const LAS bf16x8*)(KL + (32 * (qb + k5) + r) * AT_KROW + (16 * s + 8 * h) * 2); sa[k5] = MFMA32(kf, qf[s], sa[k5]); } }
        const int qi = 32 * qb + r; float mx = -INFINITY;
#pragma unroll
        for (int k5 = 0; k5 < 5; ++k5)
#pragma unroll
            for (int i = 0; i < 16; ++i) { const int kj = 32 * (qb + k5) + crow(i, h), dist = qi + BLK - kj; const bool valid = (dist >= 0) && (dist < WIN) && (n > 0 || kj >= BLK);
                const float v = valid ? sa[k5][i] * 0.125f - slope * (float)dist : -INFINITY; sa[k5][i] = v; mx = fmaxf(mx, v); }
        mx = fmaxf(mx, shx(mx, 32, C.lane)); mx = fmaxf(mx, sink);
        float sum = 0.f;
#pragma unroll
        for (int k5 = 0; k5 < 5; ++k5)
#pragma unroll
            for (int i = 0; i < 16; ++i) { const float p = __expf(sa[k5][i] - mx); sa[k5][i] = p; sum += p; }
        sum += shx(sum, 32, C.lane); sum += __expf(sink - mx);
        const float inv = 1.0f / sum;
        f32x16 o[2];
#pragma unroll
        for (int i = 0; i < 16; ++i) { o[0][i] = 0.f; o[1][i] = 0.f; }
#pragma unroll
        for (int k5 = 0; k5 < 5; ++k5)
#pragma unroll
            for (int st = 0; st < 2; ++st) { const bf16x8 pf = pack8(sa[k5], st, inv);
#pragma unroll
                for (int db = 0; db < 2; ++db) { const LAS unsigned char* vp = VL + (32 * db + r) * AT_VROW + (32 * (qb + k5) + 16 * st + 4 * h) * 2;
                    const s16x4 lo = *(const LAS s16x4*)vp, hi = *(const LAS s16x4*)(vp + 16);
                    const bf16x8 vf = __builtin_shufflevector(lo, hi, 0, 1, 2, 3, 4, 5, 6, 7);
                    o[db] = MFMA32(pf, vf, o[db]); } }
#pragma unroll
        for (int db = 0; db < 2; ++db)
#pragma unroll
            for (int i = 0; i < 16; ++i) O[(size_t)(tb + 32 * qb + crow(i, h)) * D + head * HD + 32 * db + r] = (bf16)f2bf(o[db][i]);
    }
    __syncthreads();
}

constexpr int GL_QT = 0, GL_KT = 17408, GL_KET = 34816, GL_VT = 53248, GL_GLR = 90112, GL_TOT = 94208, GL_OT = 0, GL_QROW = 272, GL_TROW = 144, GL_OROW = 260;
__device__ __forceinline__ void gla_decay(const Ctx& C, const Args& a, const bf16* __restrict__ P, int l, int h, int t0, float (&bl)[16], float& blast) {
    LAS float* GLR = (LAS float*)(C.lds + GL_GLR); LAS float* TOT = (LAS float*)(C.lds + GL_TOT);
    const int d = C.tid & 127, cg = C.tid >> 7;
    { const int idx = 2 * C.tid, c = idx >> 4, rr = idx & 15; const unsigned w = *(const unsigned*)(P + (size_t)(t0 + c) * NIN + PC_GL + rr); GLR[idx] = bf2f(w & 0xffffu); GLR[idx + 1] = bf2f(w >> 16); }
    float w2[16];
    const float* gw2 = a.in[I_GW2] + (size_t)l * GRANK * (GH * GDK) + h * GDK + d;
#pragma unroll
    for (int rr = 0; rr < 16; ++rr) w2[rr] = gw2[rr * (GH * GDK)];
    const float gb = a.in[I_GB][l * (GH * GDK) + h * GDK + d];
    __syncthreads();
    float run = 0.f;
#pragma unroll
    for (int i = 0; i < 16; ++i) { const LAS float* g = GLR + (16 * cg + i) * 16; float z = gb;
#pragma unroll
        for (int rr = 0; rr < 16; ++rr) z += g[rr] * w2[rr];
        const float ls = fminf(z, 0.f) - log1pf(expf(-fabsf(z)));
        run += ls * (1.0f / 16.0f); bl[i] = run; }
    TOT[cg * 128 + d] = run;
    __syncthreads();
    float off = 0.f, tot = 0.f;
#pragma unroll
    for (int g = 0; g < 4; ++g) { const float t = TOT[g * 128 + d]; tot += t; if (g < cg) off += t; }
#pragma unroll
    for (int i = 0; i < 16; ++i) bl[i] += off;
    blast = tot;
}
__device__ __forceinline__ void gla_stage_vt(const Ctx& C, const bf16* __restrict__ P, int h, int t0) {
    LAS unsigned char* VT = C.lds + GL_VT;
#pragma unroll
    for (int j = 0; j < 4; ++j) { const int idx = C.tid + 512 * j, c = idx >> 5, e8 = idx & 31;
        const v4u vq = *(const v4u*)(P + (size_t)(t0 + c) * NIN + PC_VG + h * GDV + 8 * e8);
        const unsigned vv[4] = {vq.x, vq.y, vq.z, vq.w};
#pragma unroll
        for (int q = 0; q < 4; ++q) { *(LAS unsigned short*)(VT + (8 * e8 + 2 * q) * GL_TROW + c * 2) = (unsigned short)(vv[q] & 0xffffu); *(LAS unsigned short*)(VT + (8 * e8 + 2 * q + 1) * GL_TROW + c * 2) = (unsigned short)(vv[q] >> 16); } }
}
__device__ __forceinline__ void gla_g1_unit(const Ctx& C, const Args& a, const bf16* __restrict__ P, int l, int ch) {
    const int h = ch & 3, n = (ch >> 2) & (NCHUNK - 1), b = ch >> 10, t0 = b * SEQ + n * GCH;
    float bl[16], blast;
    gla_decay(C, a, P, l, h, t0, bl, blast);
    const int d = C.tid & 127, cg = C.tid >> 7;
    LAS unsigned char* KET = C.lds + GL_KET;
#pragma unroll
    for (int i = 0; i < 16; ++i) { const int c = 16 * cg + i; const float k = bf2f(P[(size_t)(t0 + c) * NIN + PC_KG + h * GDK + d]);
        *(LAS unsigned short*)(KET + d * GL_TROW + c * 2) = (unsigned short)f2bf(k * expf(blast - bl[i])); }
    if (cg == 0) ((float*)(a.ws + WS_DEC))[(size_t)ch * GDK + d] = expf(blast);
    gla_stage_vt(C, P, h, t0);
    __syncthreads();
    const int r = C.lane & 31, hh = C.lane >> 5, w = C.wave;
    const LAS unsigned char* VT = C.lds + GL_VT;
    f32x16 acc[4];
#pragma unroll
    for (int db = 0; db < 4; ++db)
#pragma unroll
        for (int i = 0; i < 16; ++i) acc[db][i] = 0.f;
#pragma unroll
    for (int s = 0; s < 4; ++s) { const bf16x8 af = *(const LAS bf16x8*)(VT + (32 * w + r) * GL_TROW + (16 * s + 8 * hh) * 2);
#pragma unroll
        for (int db = 0; db < 4; ++db) { const bf16x8 bfr = *(const LAS bf16x8*)(KET + (32 * db + r) * GL_TROW + (16 * s + 8 * hh) * 2); acc[db] = MFMA32(af, bfr, acc[db]); } }
    float* kvt = (float*)(a.ws + WS_KVT) + (size_t)ch * (GDV * GDK);
#pragma unroll
    for (int db = 0; db < 4; ++db)
#pragma unroll
        for (int i = 0; i < 16; ++i) kvt[(size_t)(32 * w + crow(i, hh)) * GDK + 32 * db + r] = acc[db][i];
    __syncthreads();
}
__device__ __forceinline__ void gla_scan(const Ctx& C, const Args& a) {
    const float* __restrict__ KVT = (const float*)(a.ws + WS_KVT); const float* __restrict__ DEC = (const float*)(a.ws + WS_DEC); bf16* __restrict__ ST = (bf16*)(a.ws + WS_ST);
    for (int p = blockIdx.x * (NWAVES * 64) + C.tid; p < BATCH * GH * GDV * (GDK / 2); p += C.G * NWAVES * 64) {
        const int dp = p & 63, e = (p >> 6) & 255, bh = p >> 14, b = bh >> 2, h = bh & 3;
        float s0 = 0.f, s1 = 0.f;
#pragma unroll 8
        for (int n = 0; n < NCHUNK; ++n) { const size_t ch = (size_t)(b * NCHUNK + n) * GH + h; const size_t o = (ch * GDV + e) * GDK + 2 * dp;
            *(unsigned*)(ST + o) = pk2(s0, s1);
            const f32x2 kv = *(const f32x2*)(KVT + o), dc = *(const f32x2*)(DEC + ch * GDK + 2 * dp);
            s0 = dc.x * s0 + kv.x; s1 = dc.y * s1 + kv.y; }
    }
}
__device__ __forceinline__ void gla_g3_unit(const Ctx& C, const Args& a, const bf16* __restrict__ P, bf16* __restrict__ O, int l, int ch) {
    const int h = ch & 3, n = (ch >> 2) & (NCHUNK - 1), b = ch >> 10, t0 = b * SEQ + n * GCH;
    float bl[16], blast;
    gla_decay(C, a, P, l, h, t0, bl, blast);
    const int d = C.tid & 127, cg = C.tid >> 7;
    LAS unsigned char* QT = C.lds + GL_QT; LAS unsigned char* KT = C.lds + GL_KT; const LAS unsigned char* VT = C.lds + GL_VT;
#pragma unroll
    for (int i = 0; i < 16; ++i) { const int c = 16 * cg + i; const bf16* row = P + (size_t)(t0 + c) * NIN + h * GDK + d;
        const float q = bf2f(row[PC_QG]), k = bf2f(row[PC_KG]);
        *(LAS unsigned short*)(QT + c * GL_QROW + d * 2) = (unsigned short)f2bf(q * 0.08838834764831845f * expf(bl[i]));
        *(LAS unsigned short*)(KT + c * GL_QROW + d * 2) = (unsigned short)f2bf(k * expf(-bl[i])); }
    gla_stage_vt(C, P, h, t0);
    __syncthreads();
    const int r = C.lane & 31, hh = C.lane >> 5, w = C.wave;
    f32x16 z[2];
#pragma unroll
    for (int i = 0; i < 16; ++i) { z[0][i] = 0.f; z[1][i] = 0.f; }
    { const bf16* st = (const bf16*)(a.ws + WS_ST) + ((size_t)ch * GDV + 32 * w + r) * GDK + 8 * hh;
#pragma unroll
      for (int s = 0; s < 8; ++s) { const bf16x8 sf = *(const bf16x8*)(st + 16 * s);
#pragma unroll
          for (int cb = 0; cb < 2; ++cb) { const bf16x8 qf = *(const LAS bf16x8*)(QT + (32 * cb + r) * GL_QROW + (16 * s + 8 * hh) * 2); z[cb] = MFMA32(qf, sf, z[cb]); } } }
#pragma unroll
    for (int cb = 0; cb < 2; ++cb)
#pragma unroll
        for (int sb = 0; sb <= cb; ++sb) {
            f32x16 at;
#pragma unroll
            for (int i = 0; i < 16; ++i) at[i] = 0.f;
#pragma unroll
            for (int s = 0; s < 8; ++s) { const bf16x8 kf = *(const LAS bf16x8*)(KT + (32 * sb + r) * GL_QROW + (16 * s + 8 * hh) * 2), qf = *(const LAS bf16x8*)(QT + (32 * cb + r) * GL_QROW + (16 * s + 8 * hh) * 2); at = MFMA32(kf, qf, at); }
            if (sb == cb) {
#pragma unroll
                for (int i = 0; i < 16; ++i) at[i] = (crow(i, hh) <= r) ? at[i] : 0.f; }
#pragma unroll
            for (int st = 0; st < 2; ++st) { const bf16x8 pf = pack8(at, st, 1.0f);
                const LAS unsigned char* vp = VT + (32 * w + r) * GL_TROW + (32 * sb + 16 * st + 4 * hh) * 2;
                const s16x4 lo = *(const LAS s16x4*)vp, hi = *(const LAS s16x4*)(vp + 16);
                const bf16x8 vf = __builtin_shufflevector(lo, hi, 0, 1, 2, 3, 4, 5, 6, 7);
                z[cb] = MFMA32(pf, vf, z[cb]); }
        }
    __syncthreads();
    LAS float* OT = (LAS float*)(C.lds + GL_OT);
#pragma unroll
    for (int cb = 0; cb < 2; ++cb)
#pragma unroll
        for (int i = 0; i < 16; ++i) OT[(32 * cb + crow(i, hh)) * GL_OROW + 32 * w + r] = z[cb][i];
    __syncthreads();
    { const int c = C.tid >> 3, es = C.tid & 7;
      const LAS f32x4* orow = (const LAS f32x4*)(OT + c * GL_OROW + 32 * es);
      f32x4 v[8]; float ss = 0.f;
#pragma unroll
      for (int j = 0; j < 8; ++j) { v[j] = orow[j]; ss += (v[j].x * v[j].x + v[j].y * v[j].y) + (v[j].z * v[j].z + v[j].w * v[j].w); }
      ss += shx(ss, 1, C.lane); ss += shx(ss, 2, C.lane); ss += shx(ss, 4, C.lane);
      const float rinv = 1.0f / sqrtf(ss * (1.0f / GDV) + EPS);
      const bf16* rrow = P + (size_t)(t0 + c) * NIN + PC_RG + h * GDV + 32 * es;
      const float* nw = a.in[I_GNORM] + (size_t)l * GDV + 32 * es;
      bf16* orow_g = O + (size_t)(t0 + c) * D + D / 2 + h * GDV + 32 * es;
#pragma unroll
      for (int j = 0; j < 4; ++j) { const v4u rq = *(const v4u*)(rrow + 8 * j); const f32x4 w0 = *(const f32x4*)(nw + 8 * j), w1 = *(const f32x4*)(nw + 8 * j + 4);
          const unsigned rr[4] = {rq.x, rq.y, rq.z, rq.w}; const f32x4 x0 = v[2 * j], x1 = v[2 * j + 1];
          float y[8];
          const float r0 = bf2f(rr[0] & 0xffffu), r1 = bf2f(rr[0] >> 16), r2 = bf2f(rr[1] & 0xffffu), r3 = bf2f(rr[1] >> 16), r4 = bf2f(rr[2] & 0xffffu), r5 = bf2f(rr[2] >> 16), r6 = bf2f(rr[3] & 0xffffu), r7 = bf2f(rr[3] >> 16);
          y[0] = x0.x * rinv * w0.x * pg8::silu_f(r0); y[1] = x0.y * rinv * w0.y * pg8::silu_f(r1); y[2] = x0.z * rinv * w0.z * pg8::silu_f(r2); y[3] = x0.w * rinv * w0.w * pg8::silu_f(r3);
          y[4] = x1.x * rinv * w1.x * pg8::silu_f(r4); y[5] = x1.y * rinv * w1.y * pg8::silu_f(r5); y[6] = x1.z * rinv * w1.z * pg8::silu_f(r6); y[7] = x1.w * rinv * w1.w * pg8::silu_f(r7);
          v4u o; o.x = pk2(y[0], y[1]); o.y = pk2(y[2], y[3]); o.z = pk2(y[4], y[5]); o.w = pk2(y[6], y[7]);
          *(v4u*)(orow_g + 8 * j) = o; } }
    __syncthreads();
}

typedef short v4i16_t __attribute__((ext_vector_type(4)));
__device__ __forceinline__ s16x4 lds_tr16(const LAS unsigned char* p) { return __builtin_bit_cast(s16x4, __builtin_amdgcn_ds_read_tr16_b64_v4i16((LAS v4i16_t*)p)); }
__device__ __forceinline__ bf16x8 cat8(s16x4 lo, s16x4 hi) { return __builtin_shufflevector(lo, hi, 0, 1, 2, 3, 4, 5, 6, 7); }

constexpr int A2_K_OFF = 0, A2_V_OFF = 256 * 144, A2_O_OFF = A2_V_OFF + 256 * 128, A2_OROW = 144, A2_OWAVE = 32 * A2_OROW;
static_assert(A2_O_OFF + 8 * A2_OWAVE <= RING_BYTES, "attention LDS");
__device__ __forceinline__ void attn_unit2(const Ctx& C, const bf16* __restrict__ P, bf16* __restrict__ O, const float* sinks, int unit) {
    const int kv = unit & 1, n = (unit >> 1) & (NBLK - 1), b = unit >> 8;
    const int tb = b * SEQ + n * BLK;
    LAS unsigned char* KL = C.lds + A2_K_OFF; LAS unsigned char* VL = C.lds + A2_V_OFF; LAS unsigned char* OL = C.lds + A2_O_OFF + C.wave * A2_OWAVE;
    const int r = C.lane & 31, h = C.lane >> 5, head = kv * GQA + C.wave;
    v4u kq[4], vq[4];
#pragma unroll
    for (int j = 0; j < 4; ++j) { const int idx = C.tid + 512 * j, key = idx >> 3, part = idx & 7;
        kq[j] = (v4u){0u, 0u, 0u, 0u}; vq[j] = kq[j];
        if (n > 0 || key >= BLK) { const bf16* row = P + (size_t)(tb + key - BLK) * NIN; kq[j] = *(const v4u*)(row + PC_KA + kv * HD + 8 * part); vq[j] = *(const v4u*)(row + PC_VA + kv * HD + 8 * part); } }
    const bf16* qbase = P + (size_t)(tb + r) * NIN + PC_QA + head * HD + 8 * h;
    bf16x8 qf[4], qn[4];
#pragma unroll
    for (int s = 0; s < 4; ++s) { qf[s] = *(const bf16x8*)(qbase + 16 * s); qn[s] = qf[s]; }
#pragma unroll
    for (int j = 0; j < 4; ++j) { const int idx = C.tid + 512 * j, key = idx >> 3, part = idx & 7;
        *(LAS v4u*)(KL + key * 144 + part * 16) = kq[j];
        *(LAS v4u*)(VL + key * 128 + ((part * 16) ^ (((key >> 1) & 1) << 6))) = vq[j]; }
    __syncthreads();
    const float slope = exp2f(-0.5f * (float)(head + 1)) * 1.44269504089f, sink = sinks[head] * 1.44269504089f;
    const int ibase = r - 4 * h + BLK; const float nb = -slope * (float)ibase;
    const int tq = (C.lane & 15) >> 2, tp = C.lane & 3, tblk = (C.lane >> 4) & 1;
    const int vtr_off = tq * 128 + ((32 * tblk + 8 * tp) ^ (((tq >> 1) & 1) << 6));
#pragma unroll 1
    for (int qb = 0; qb < 4; ++qb) {
        if (qb < 3) {
#pragma unroll
            for (int s = 0; s < 4; ++s) qn[s] = *(const bf16x8*)(qbase + (size_t)(32 * (qb + 1)) * NIN + 16 * s); }
        f32x16 sa[5];
#pragma unroll
        for (int k5 = 0; k5 < 5; ++k5) {
#pragma unroll
            for (int i = 0; i < 16; ++i) sa[k5][i] = 0.f;
#pragma unroll
            for (int s = 0; s < 4; ++s) { const bf16x8 kf = *(const LAS bf16x8*)(KL + (32 * (qb + k5) + r) * 144 + (16 * s + 8 * h) * 2); sa[k5] = MFMA32(kf, qf[s], sa[k5]); } }
        float mx = -INFINITY;
#pragma unroll
        for (int k5 = 0; k5 < 5; ++k5)
#pragma unroll
            for (int i = 0; i < 16; ++i) { const int c = 32 * k5 + (i & 3) + 8 * (i >> 2);
                float v = __builtin_fmaf(sa[k5][i], 0.125f * 1.44269504089f, __builtin_fmaf(slope, (float)c, nb));
                if (k5 == 0) v = (ibase - c < WIN) ? v : -INFINITY;
                if (k5 == 4) v = (ibase >= c) ? v : -INFINITY;
                sa[k5][i] = v; }
        if (n == 0) {
#pragma unroll
            for (int k5 = 0; k5 < 5; ++k5)
#pragma unroll
                for (int i = 0; i < 16; ++i) { const int kj = 32 * (qb + k5) + crow(i, h); if (kj < BLK) sa[k5][i] = -INFINITY; } }
#pragma unroll
        for (int k5 = 0; k5 < 5; ++k5)
#pragma unroll
            for (int i = 0; i < 16; ++i) mx = fmaxf(mx, sa[k5][i]);
        mx = fmaxf(mx, shx(mx, 32, C.lane)); mx = fmaxf(mx, sink);
        float sum = 0.f;
#pragma unroll
        for (int k5 = 0; k5 < 5; ++k5)
#pragma unroll
            for (int i = 0; i < 16; ++i) { const float p = __builtin_amdgcn_exp2f(sa[k5][i] - mx); sa[k5][i] = p; sum += p; }
        sum += shx(sum, 32, C.lane); sum += __builtin_amdgcn_exp2f(sink - mx);
        const float inv = 1.0f / sum;
        f32x16 ot[2];
#pragma unroll
        for (int i = 0; i < 16; ++i) { ot[0][i] = 0.f; ot[1][i] = 0.f; }
#pragma unroll
        for (int k5 = 0; k5 < 5; ++k5)
#pragma unroll
            for (int st = 0; st < 2; ++st) { const bf16x8 pf = pack8(sa[k5], st, 1.0f);
                const int key0 = 32 * (qb + k5) + 16 * st + 4 * h;
#pragma unroll
                for (int db = 0; db < 2; ++db) { const LAS unsigned char* vp = VL + key0 * 128 + (vtr_off ^ (64 * db));
                    const bf16x8 vf = cat8(lds_tr16(vp), lds_tr16(vp + 8 * 128));
                    ot[db] = MFMA32(vf, pf, ot[db]); } }
#pragma unroll
        for (int db = 0; db < 2; ++db)
#pragma unroll
            for (int g = 0; g < 4; ++g) { v2u w; w.x = pk2(ot[db][4 * g] * inv, ot[db][4 * g + 1] * inv); w.y = pk2(ot[db][4 * g + 2] * inv, ot[db][4 * g + 3] * inv);
                *(LAS v2u*)(OL + r * A2_OROW + (32 * db + 8 * g + 4 * h) * 2) = w; }
#pragma unroll
        for (int j = 0; j < 4; ++j) { const int row = (C.lane >> 3) + 8 * j, part = C.lane & 7;
            const v4u w = *(const LAS v4u*)(OL + row * A2_OROW + part * 16);
            *(v4u*)(O + (size_t)(tb + 32 * qb + row) * D + head * HD + 8 * part) = w; }
#pragma unroll
        for (int s = 0; s < 4; ++s) qf[s] = qn[s];
    }
    __syncthreads();
}

constexpr int G2_QT = 0, G2_KT = 17408, G2_VR = 34816, G2_GLR = 67584, G2_TOT = 71680, G2_QROW = 272, G2_KEROW = 320, G2_OROW = 260;
static_assert(64 * G2_KEROW <= G2_VR && 64 * G2_OROW * 4 <= G2_GLR, "GLA LDS");
__device__ __forceinline__ void gla_decay2(const Ctx& C, const Args& a, unsigned glr, int l, int h, float (&bl)[16], float& blast) {
    LAS float* GLR = (LAS float*)(C.lds + G2_GLR); LAS float* TOT = (LAS float*)(C.lds + G2_TOT);
    const int d = C.tid & 127, cg = C.tid >> 7;
    GLR[2 * C.tid] = bf2f(glr & 0xffffu); GLR[2 * C.tid + 1] = bf2f(glr >> 16);
    float w2[16];
    const float* gw2 = a.in[I_GW2] + (size_t)l * GRANK * (GH * GDK) + h * GDK + d;
#pragma unroll
    for (int rr = 0; rr < 16; ++rr) w2[rr] = gw2[rr * (GH * GDK)];
    const float gb = a.in[I_GB][l * (GH * GDK) + h * GDK + d];
    __syncthreads();
    float run = 0.f;
#pragma unroll
    for (int i = 0; i < 16; ++i) { const LAS f32x4* g = (const LAS f32x4*)(GLR + (16 * cg + i) * 16); float z = gb;
#pragma unroll
        for (int q4 = 0; q4 < 4; ++q4) { const f32x4 gg = g[q4]; z += gg.x * w2[4 * q4] + gg.y * w2[4 * q4 + 1] + gg.z * w2[4 * q4 + 2] + gg.w * w2[4 * q4 + 3]; }
        const float ls = fminf(z, 0.f) - __logf(1.0f + __expf(-fabsf(z)));
        run += ls * (1.0f / 16.0f); bl[i] = run; }
    TOT[cg * 128 + d] = run;
    __syncthreads();
    float off = 0.f, tot = 0.f;
#pragma unroll
    for (int g = 0; g < 4; ++g) { const float t = TOT[g * 128 + d]; tot += t; if (g < cg) off += t; }
#pragma unroll
    for (int i = 0; i < 16; ++i) bl[i] += off;
    blast = tot;
}
__device__ __forceinline__ void gla_g1_unit2(const Ctx& C, const Args& a, const bf16* __restrict__ P, int l, int ch) {
    const int h = ch & 3, n = (ch >> 2) & (NCHUNK - 1), b = ch >> 10, t0 = b * SEQ + n * GCH;
    LAS unsigned char* KE = C.lds + G2_QT; LAS unsigned char* VR = C.lds + G2_VR;
    v4u kq[2], vq[4];
#pragma unroll
    for (int j = 0; j < 2; ++j) { const int idx = C.tid + 512 * j, c = idx >> 4, p16 = idx & 15; kq[j] = *(const v4u*)(P + (size_t)(t0 + c) * NIN + PC_KG + h * GDK + 8 * p16); }
#pragma unroll
    for (int j = 0; j < 4; ++j) { const int idx = C.tid + 512 * j, c = idx >> 5, e8 = idx & 31; vq[j] = *(const v4u*)(P + (size_t)(t0 + c) * NIN + PC_VG + h * GDV + 8 * e8); }
    const unsigned glr = *(const unsigned*)(P + (size_t)(t0 + (C.tid >> 3)) * NIN + PC_GL + 2 * (C.tid & 7));
#pragma unroll
    for (int j = 0; j < 2; ++j) { const int idx = C.tid + 512 * j, c = idx >> 4, p16 = idx & 15; *(LAS v4u*)(KE + c * G2_KEROW + 16 * p16) = kq[j]; }
#pragma unroll
    for (int j = 0; j < 4; ++j) { const int idx = C.tid + 512 * j, c = idx >> 5, e8 = idx & 31; *(LAS v4u*)(VR + c * 512 + ((16 * e8) ^ ((c & 3) << 6))) = vq[j]; }
    float bl[16], blast;
    gla_decay2(C, a, glr, l, h, bl, blast);
    const int d = C.tid & 127, cg = C.tid >> 7;
#pragma unroll
    for (int i = 0; i < 16; ++i) { LAS unsigned short* kp = (LAS unsigned short*)(KE + (16 * cg + i) * G2_KEROW + 2 * d); *kp = (unsigned short)f2bf(bf2f(*kp) * __expf(blast - bl[i])); }
    if (cg == 0) ((float*)(a.ws + WS_DEC))[(size_t)ch * GDK + d] = __expf(blast);
    __syncthreads();
    const int r = C.lane & 31, hh = C.lane >> 5, w = C.wave;
    const int tq = (C.lane & 15) >> 2, tp = C.lane & 3, tblk = (C.lane >> 4) & 1;
    f32x16 acc[4];
#pragma unroll
    for (int db = 0; db < 4; ++db)
#pragma unroll
        for (int i = 0; i < 16; ++i) acc[db][i] = 0.f;
#pragma unroll
    for (int s = 0; s < 4; ++s) { const int c0 = 16 * s + 8 * hh;
        const LAS unsigned char* vp = VR + (c0 + tq) * 512 + ((64 * w + 32 * tblk + 8 * tp) ^ (tq << 6));
        const bf16x8 af = cat8(lds_tr16(vp), lds_tr16(vp + 4 * 512));
#pragma unroll
        for (int db = 0; db < 4; ++db) { const LAS unsigned char* kp = KE + (c0 + tq) * G2_KEROW + 64 * db + 32 * tblk + 8 * tp;
            const bf16x8 bfr = cat8(lds_tr16(kp), lds_tr16(kp + 4 * G2_KEROW));
            acc[db] = MFMA32(af, bfr, acc[db]); } }
    float* kvt = (float*)(a.ws + WS_KVT) + (size_t)ch * (GDV * GDK);
#pragma unroll
    for (int db = 0; db < 4; ++db)
#pragma unroll
        for (int i = 0; i < 16; ++i) kvt[(size_t)(32 * w + crow(i, hh)) * GDK + 32 * db + r] = acc[db][i];
    __syncthreads();
}
__device__ __forceinline__ void gla_g3_unit2(const Ctx& C, const Args& a, const bf16* __restrict__ P, bf16* __restrict__ O, int l, int ch) {
    const int h = ch & 3, n = (ch >> 2) & (NCHUNK - 1), b = ch >> 10, t0 = b * SEQ + n * GCH;
    LAS unsigned char* QT = C.lds + G2_QT; LAS unsigned char* KT = C.lds + G2_KT; LAS unsigned char* VR = C.lds + G2_VR;
    const int r = C.lane & 31, hh = C.lane >> 5, w = C.wave;
    v4u qq[2], kq[2], vq[4];
#pragma unroll
    for (int j = 0; j < 2; ++j) { const int idx = C.tid + 512 * j, c = idx >> 4, p16 = idx & 15; const bf16* row = P + (size_t)(t0 + c) * NIN + h * GDK + 8 * p16; qq[j] = *(const v4u*)(row + PC_QG); kq[j] = *(const v4u*)(row + PC_KG); }
#pragma unroll
    for (int j = 0; j < 4; ++j) { const int idx = C.tid + 512 * j, c = idx >> 5, e8 = idx & 31; vq[j] = *(const v4u*)(P + (size_t)(t0 + c) * NIN + PC_VG + h * GDV + 8 * e8); }
    const unsigned glr = *(const unsigned*)(P + (size_t)(t0 + (C.tid >> 3)) * NIN + PC_GL + 2 * (C.tid & 7));
    bf16x8 sf[8];
    { const bf16* st = (const bf16*)(a.ws + WS_ST) + ((size_t)ch * GDV + 32 * w + r) * GDK + 8 * hh;
#pragma unroll
      for (int s = 0; s < 8; ++s) sf[s] = *(const bf16x8*)(st + 16 * s); }
    v4u rq[4];
    { const bf16* rrow = P + (size_t)(t0 + (C.tid >> 3)) * NIN + PC_RG + h * GDV + 32 * (C.tid & 7);
#pragma unroll
      for (int j = 0; j < 4; ++j) rq[j] = *(const v4u*)(rrow + 8 * j); }
#pragma unroll
    for (int j = 0; j < 2; ++j) { const int idx = C.tid + 512 * j, c = idx >> 4, p16 = idx & 15; *(LAS v4u*)(QT + c * G2_QROW + 16 * p16) = qq[j]; *(LAS v4u*)(KT + c * G2_QROW + 16 * p16) = kq[j]; }
#pragma unroll
    for (int j = 0; j < 4; ++j) { const int idx = C.tid + 512 * j, c = idx >> 5, e8 = idx & 31; *(LAS v4u*)(VR + c * 512 + ((16 * e8) ^ ((c & 3) << 6))) = vq[j]; }
    float bl[16], blast;
    gla_decay2(C, a, glr, l, h, bl, blast);
    { const int d = C.tid & 127, cg = C.tid >> 7;
#pragma unroll
      for (int i = 0; i < 16; ++i) { LAS unsigned short* qp = (LAS unsigned short*)(QT + (16 * cg + i) * G2_QROW + 2 * d); LAS unsigned short* kp = (LAS unsigned short*)(KT + (16 * cg + i) * G2_QROW + 2 * d);
          *qp = (unsigned short)f2bf(bf2f(*qp) * 0.08838834764831845f * __expf(bl[i])); *kp = (unsigned short)f2bf(bf2f(*kp) * __expf(-bl[i])); } }
    __syncthreads();
    const int tq = (C.lane & 15) >> 2, tp = C.lane & 3, tblk = (C.lane >> 4) & 1;
    f32x16 z[2];
#pragma unroll
    for (int i = 0; i < 16; ++i) { z[0][i] = 0.f; z[1][i] = 0.f; }
#pragma unroll
    for (int s = 0; s < 8; ++s)
#pragma unroll
        for (int cb = 0; cb < 2; ++cb) { const bf16x8 qf = *(const LAS bf16x8*)(QT + (32 * cb + r) * G2_QROW + (16 * s + 8 * hh) * 2); z[cb] = MFMA32(qf, sf[s], z[cb]); }
#pragma unroll
    for (int cb = 0; cb < 2; ++cb)
#pragma unroll
        for (int sb = 0; sb <= cb; ++sb) {
            f32x16 at;
#pragma unroll
            for (int i = 0; i < 16; ++i) at[i] = 0.f;
#pragma unroll
            for (int s = 0; s < 8; ++s) { const bf16x8 kf = *(const LAS bf16x8*)(KT + (32 * sb + r) * G2_QROW + (16 * s + 8 * hh) * 2), qf = *(const LAS bf16x8*)(QT + (32 * cb + r) * G2_QROW + (16 * s + 8 * hh) * 2); at = MFMA32(kf, qf, at); }
            if (sb == cb) {
#pragma unroll
                for (int i = 0; i < 16; ++i) at[i] = (crow(i, hh) <= r) ? at[i] : 0.f; }
#pragma unroll
            for (int st = 0; st < 2; ++st) { const bf16x8 pf = pack8(at, st, 1.0f);
                const int c0 = 32 * sb + 16 * st + 4 * hh;
                const LAS unsigned char* vp = VR + (c0 + tq) * 512 + ((64 * w + 32 * tblk + 8 * tp) ^ (tq << 6));
                const bf16x8 vf = cat8(lds_tr16(vp), lds_tr16(vp + 8 * 512));
                z[cb] = MFMA32(pf, vf, z[cb]); }
        }
    __syncthreads();
    LAS float* OT = (LAS float*)(C.lds + G2_QT);
#pragma unroll
    for (int cb = 0; cb < 2; ++cb)
#pragma unroll
        for (int i = 0; i < 16; ++i) OT[(32 * cb + crow(i, hh)) * G2_OROW + 32 * w + r] = z[cb][i];
    __syncthreads();
    { const int c = C.tid >> 3, es = C.tid & 7;
      const LAS f32x4* orow = (const LAS f32x4*)(OT + c * G2_OROW + 32 * es);
      f32x4 v[8]; float ss = 0.f;
#pragma unroll
      for (int j = 0; j < 8; ++j) { v[j] = orow[j]; ss += (v[j].x * v[j].x + v[j].y * v[j].y) + (v[j].z * v[j].z + v[j].w * v[j].w); }
      ss += shx(ss, 1, C.lane); ss += shx(ss, 2, C.lane); ss += shx(ss, 4, C.lane);
      const float rinv = 1.0f / sqrtf(ss * (1.0f / GDV) + EPS);
      const float* nw = a.in[I_GNORM] + (size_t)l * GDV + 32 * es;
      bf16* orow_g = O + (size_t)(t0 + c) * D + D / 2 + h * GDV + 32 * es;
#pragma unroll
      for (int j = 0; j < 4; ++j) { const f32x4 w0 = *(const f32x4*)(nw + 8 * j) * rinv, w1 = *(const f32x4*)(nw + 8 * j + 4) * rinv;
          const f32x4 x0 = v[2 * j], x1 = v[2 * j + 1];
          const float r0 = bf2f(rq[j].x & 0xffffu), r1 = bf2f(rq[j].x >> 16), r2 = bf2f(rq[j].y & 0xffffu), r3 = bf2f(rq[j].y >> 16), r4 = bf2f(rq[j].z & 0xffffu), r5 = bf2f(rq[j].z >> 16), r6 = bf2f(rq[j].w & 0xffffu), r7 = bf2f(rq[j].w >> 16);
          v4u o; o.x = pk2(x0.x * w0.x * pg8::silu_f(r0), x0.y * w0.y * pg8::silu_f(r1)); o.y = pk2(x0.z * w0.z * pg8::silu_f(r2), x0.w * w0.w * pg8::silu_f(r3));
          o.z = pk2(x1.x * w1.x * pg8::silu_f(r4), x1.y * w1.y * pg8::silu_f(r5)); o.w = pk2(x1.z * w1.z * pg8::silu_f(r6), x1.w * w1.w * pg8::silu_f(r7));
          *(v4u*)(orow_g + 8 * j) = o; } }
    __syncthreads();
}

constexpr int G3_NW = 94720 + 17 * 128 * 4;
static_assert(G3_NW + 1024 <= RING_BYTES, "G3 norm weights in LDS");
constexpr int G3_GW = 94720;
constexpr int GG = 8, NGRP = NCHUNK / GG;
constexpr int G3_QT = 0, G3_KT = 17408, G3_VR = 34816, G3_KE = 67584, G3_GLR = 88064, G3_TOT = 92160, G3_DL = 94208, G3_QROW = 272, G3_KEROW = 320, G3_OROW = 260;
static_assert(G3_KE + 64 * G3_KEROW <= G3_GLR && 64 * G3_OROW * 4 <= G3_KE && G3_DL + 512 <= RING_BYTES, "GLA group LDS");
__device__ __forceinline__ void gla_decay3(const Ctx& C, const Args& a, unsigned glr, int l, int h, float (&bl)[16], float& blast) {
    LAS float* GLR = (LAS float*)(C.lds + G3_GLR); LAS float* TOT = (LAS float*)(C.lds + G3_TOT);
    const int d = C.tid & 127, cg = C.tid >> 7;
    GLR[2 * C.tid] = bf2f(glr & 0xffffu); GLR[2 * C.tid + 1] = bf2f(glr >> 16);
    float w2[16];
    const LAS float* GW = (const LAS float*)(C.lds + G3_GW);
#pragma unroll
    for (int rr = 0; rr < 16; ++rr) w2[rr] = GW[rr * 128 + d];
    const float gb = GW[16 * 128 + d];
    __syncthreads();
    float run = 0.f;
#pragma unroll
    for (int i = 0; i < 16; ++i) { const LAS f32x4* g = (const LAS f32x4*)(GLR + (16 * cg + i) * 16); float z = gb;
#pragma unroll
        for (int q4 = 0; q4 < 4; ++q4) { const f32x4 gg = g[q4]; z += gg.x * w2[4 * q4] + gg.y * w2[4 * q4 + 1] + gg.z * w2[4 * q4 + 2] + gg.w * w2[4 * q4 + 3]; }
        const float ls = fminf(z, 0.f) - __logf(1.0f + __expf(-fabsf(z)));
        run += ls * (1.0f / 16.0f); bl[i] = run; }
    TOT[cg * 128 + d] = run;
    __syncthreads();
    float off = 0.f, tot = 0.f;
#pragma unroll
    for (int g = 0; g < 4; ++g) { const float t = TOT[g * 128 + d]; tot += t; if (g < cg) off += t; }
#pragma unroll
    for (int i = 0; i < 16; ++i) bl[i] += off;
    blast = tot;
}
__device__ __forceinline__ void gla_g1_grp(const Ctx& C, const Args& a, const bf16* __restrict__ P, int l, int gu) {
    const int h = gu & 3, grp = (gu >> 2) & (NGRP - 1), b = gu >> 7;
    LAS unsigned char* KE = C.lds + G3_KE; LAS unsigned char* VR = C.lds + G3_VR; LAS float* DL = (LAS float*)(C.lds + G3_DL);
    const int r = C.lane & 31, hh = C.lane >> 5, w = C.wave, d = C.tid & 127, cg = C.tid >> 7;
    const int tq = (C.lane & 15) >> 2, tp = C.lane & 3, tblk = (C.lane >> 4) & 1;
    f32x16 acc[4];
#pragma unroll
    for (int db = 0; db < 4; ++db)
#pragma unroll
        for (int i = 0; i < 16; ++i) acc[db][i] = 0.f;
    { LAS float* GW = (LAS float*)(C.lds + G3_GW);
#pragma unroll
      for (int k = 0; k < 4; ++k) { const int i = C.tid + 512 * k, rr = i >> 7, dd = i & 127; GW[i] = a.in[I_GW2][(size_t)l * GRANK * (GH * GDK) + rr * (GH * GDK) + h * GDK + dd]; }
      if (C.tid < 128) GW[16 * 128 + C.tid] = a.in[I_GB][l * (GH * GDK) + h * GDK + C.tid];
      __syncthreads(); }
    float bsum = 0.f;
    v4u kq[2], vq[4]; unsigned glr;
    { const int t0 = b * SEQ + (grp * GG) * GCH;
#pragma unroll
      for (int i = 0; i < 2; ++i) { const int idx = C.tid + 512 * i, c = idx >> 4, p16 = idx & 15; kq[i] = *(const v4u*)(P + (size_t)(t0 + c) * NIN + PC_KG + h * GDK + 8 * p16); }
#pragma unroll
      for (int i = 0; i < 4; ++i) { const int idx = C.tid + 512 * i, c = idx >> 5, e8 = idx & 31; vq[i] = *(const v4u*)(P + (size_t)(t0 + c) * NIN + PC_VG + h * GDV + 8 * e8); }
      glr = *(const unsigned*)(P + (size_t)(t0 + (C.tid >> 3)) * NIN + PC_GL + 2 * (C.tid & 7)); }
#pragma unroll 1
    for (int j = 0; j < GG; ++j) {
        const int t0 = b * SEQ + (grp * GG + j) * GCH;
#pragma unroll
        for (int i = 0; i < 2; ++i) { const int idx = C.tid + 512 * i, c = idx >> 4, p16 = idx & 15; *(LAS v4u*)(KE + c * G3_KEROW + 16 * p16) = kq[i]; }
#pragma unroll
        for (int i = 0; i < 4; ++i) { const int idx = C.tid + 512 * i, c = idx >> 5, e8 = idx & 31; *(LAS v4u*)(VR + c * 512 + ((16 * e8) ^ ((c & 3) << 6))) = vq[i]; }
        const unsigned glr_cur = glr;
        if (j + 1 < GG) { const int t1 = t0 + GCH;
#pragma unroll
            for (int i = 0; i < 2; ++i) { const int idx = C.tid + 512 * i, c = idx >> 4, p16 = idx & 15; kq[i] = *(const v4u*)(P + (size_t)(t1 + c) * NIN + PC_KG + h * GDK + 8 * p16); }
#pragma unroll
            for (int i = 0; i < 4; ++i) { const int idx = C.tid + 512 * i, c = idx >> 5, e8 = idx & 31; vq[i] = *(const v4u*)(P + (size_t)(t1 + c) * NIN + PC_VG + h * GDV + 8 * e8); }
            glr = *(const unsigned*)(P + (size_t)(t1 + (C.tid >> 3)) * NIN + PC_GL + 2 * (C.tid & 7)); }
        float bl[16], blast;
        gla_decay3(C, a, glr_cur, l, h, bl, blast);
        bsum += blast;
#pragma unroll
        for (int i = 0; i < 16; ++i) { LAS unsigned short* kp = (LAS unsigned short*)(KE + (16 * cg + i) * G3_KEROW + 2 * d); *kp = (unsigned short)f2bf(bf2f(*kp) * __expf(blast - bl[i])); }
        if (cg == 0) DL[d] = __expf(blast);
        __syncthreads();
#pragma unroll
        for (int db = 0; db < 4; ++db) { const float dc = DL[32 * db + r];
#pragma unroll
            for (int i = 0; i < 16; ++i) acc[db][i] *= dc; }
#pragma unroll
        for (int s = 0; s < 4; ++s) { const int c0 = 16 * s + 8 * hh;
            const LAS unsigned char* vp = VR + (c0 + tq) * 512 + ((64 * w + 32 * tblk + 8 * tp) ^ (tq << 6));
            const bf16x8 af = cat8(lds_tr16(vp), lds_tr16(vp + 4 * 512));
#pragma unroll
            for (int db = 0; db < 4; ++db) { const LAS unsigned char* kp = KE + (c0 + tq) * G3_KEROW + 64 * db + 32 * tblk + 8 * tp;
                const bf16x8 bfr = cat8(lds_tr16(kp), lds_tr16(kp + 4 * G3_KEROW));
                acc[db] = MFMA32(af, bfr, acc[db]); } }
        __syncthreads();
    }
    float* kvt = (float*)(a.ws + WS_KVT) + (size_t)gu * (GDV * GDK);
#pragma unroll
    for (int db = 0; db < 4; ++db)
#pragma unroll
        for (int i = 0; i < 16; ++i) kvt[(size_t)(32 * w + crow(i, hh)) * GDK + 32 * db + r] = acc[db][i];
    if (cg == 0) ((float*)(a.ws + WS_DEC))[(size_t)gu * GDK + d] = __expf(bsum);
}
__device__ __forceinline__ void tok0_row(const Ctx& C, const Args& a, const _Float16* hs, const float* w, const float* shv, const float* scv, int bstride) {
    float* u0 = (float*)(a.ws + WS_TOK0);
    if (C.gw < BATCH) { const int b = C.gw, m = b * SEQ;
        const h16x8n* xr = (const h16x8n*)(hs + (size_t)m * D) + C.lane; f32x4 v[8]; float s = 0.f;
#pragma unroll
        for (int j = 0; j < 4; ++j) { const f32x8n f = __builtin_convertvector(xr[64 * j], f32x8n); v[2 * j] = (f32x4){f[0], f[1], f[2], f[3]}; v[2 * j + 1] = (f32x4){f[4], f[5], f[6], f[7]}; }
#pragma unroll
        for (int j = 0; j < 8; ++j) s += (v[j].x * v[j].x + v[j].y * v[j].y) + (v[j].z * v[j].z + v[j].w * v[j].w);
        const float r = 1.0f / sqrtf(wave_sum(s, C.lane) * (1.0f / D) + EPS);
#pragma unroll
        for (int j = 0; j < 8; ++j) { const int col = 8 * (C.lane + 64 * (j >> 1)) + 4 * (j & 1);
            const f32x4 y = v[j] * r * (*(const f32x4*)(w + col) * (*(const f32x4*)(scv + (size_t)b * bstride + col) + 1.0f)) + *(const f32x4*)(shv + (size_t)b * bstride + col);
            *(f32x4*)(u0 + (size_t)b * D + col) = y; } }
}
constexpr int T0_PART = 8192;
__device__ __forceinline__ void tok0_qk_partial(const Ctx& C, const Args& a, int l) {
    const float* u0 = (const float*)(a.ws + WS_TOK0); float* part = (float*)(a.ws + WS_TOK0) + T0_PART;
    for (int it = C.gw; it < 64 * 16; it += C.NGW) { const int ks = it >> 4, cg = it & 15, col = 64 * cg + C.lane;
        const float* wp = a.in[I_WIN] + (size_t)l * D * NINR + (size_t)(32 * ks) * NINR + PC_QG + col;
        float wv[32];
#pragma unroll
        for (int j = 0; j < 32; ++j) wv[j] = wp[(size_t)j * NINR];
        const int ua = __builtin_bit_cast(int, u0[32 * ks + (C.lane & 31)]), ub = __builtin_bit_cast(int, u0[D + 32 * ks + (C.lane & 31)]);
        float s0 = 0.f, s1 = 0.f;
#pragma unroll
        for (int j = 0; j < 32; ++j) { s0 += __builtin_bit_cast(float, __builtin_amdgcn_readlane(ua, j)) * wv[j]; s1 += __builtin_bit_cast(float, __builtin_amdgcn_readlane(ub, j)) * wv[j]; }
        part[(size_t)(ks * 2 + 0) * 1024 + col] = s0; part[(size_t)(ks * 2 + 1) * 1024 + col] = s1; }
}
__device__ __forceinline__ void tok0_qk_reduce(const Ctx& C, const Args& a) {
    const float* part = (const float*)(a.ws + WS_TOK0) + T0_PART; float* qk0 = (float*)(a.ws + WS_TOK0) + BATCH * D;
    for (int id = C.gw; id < BATCH * 2 * GH * GDK; id += C.NGW) { const int b = id >> 10, col = id & 1023;
        const float s = wave_sum(part[(size_t)(C.lane * 2 + b) * 1024 + col], C.lane);
        qk0[(size_t)b * 1024 + col] = s; }
}
__device__ __forceinline__ void gla_scan_grp(const Ctx& C, const Args& a) {
    const float* __restrict__ KVT = (const float*)(a.ws + WS_KVT); const float* __restrict__ DEC = (const float*)(a.ws + WS_DEC); bf16* __restrict__ ST = (bf16*)(a.ws + WS_ST);
    for (int p = blockIdx.x * (NWAVES * 64) + C.tid; p < BATCH * GH * GDV * (GDK / 2); p += C.G * NWAVES * 64) {
        const int dp = p & 63, e = (p >> 6) & 255, bh = p >> 14, b = bh >> 2, h = bh & 3;
        f32x2 kv[NGRP], dc[NGRP];
#pragma unroll
        for (int g = 0; g < NGRP; ++g) { const size_t gu = (size_t)(b * NGRP + g) * GH + h; const size_t o = (gu * GDV + e) * GDK + 2 * dp;
            kv[g] = *(const f32x2*)(KVT + o); dc[g] = *(const f32x2*)(DEC + gu * GDK + 2 * dp); }
        float s0 = 0.f, s1 = 0.f;
#pragma unroll
        for (int g = 0; g < NGRP; ++g) { const size_t gu = (size_t)(b * NGRP + g) * GH + h; const size_t o = (gu * GDV + e) * GDK + 2 * dp;
            *(unsigned*)(ST + o) = pk2(s0, s1);
            s0 = dc[g].x * s0 + kv[g].x; s1 = dc[g].y * s1 + kv[g].y; }
    }
}
__device__ __forceinline__ void gla_g3_grp(const Ctx& C, const Args& a, const bf16* __restrict__ P, bf16* __restrict__ O, int l, int gu) {
    const int h = gu & 3, grp = (gu >> 2) & (NGRP - 1), b = gu >> 7;
    LAS unsigned char* QT = C.lds + G3_QT; LAS unsigned char* KT = C.lds + G3_KT; LAS unsigned char* VR = C.lds + G3_VR; LAS unsigned char* KE = C.lds + G3_KE; LAS float* DL = (LAS float*)(C.lds + G3_DL);
    const int w = C.wave;
    float a00 = 0.f;
    if (grp == 0) { const float* qk0 = (const float*)(a.ws + WS_TOK0) + BATCH * D + (size_t)b * 1024 + h * GDK;
        a00 = wave_sum(qk0[C.lane] * qk0[512 + C.lane] + qk0[64 + C.lane] * qk0[512 + 64 + C.lane], C.lane) * 0.08838834764831845f; }
    f32x16 S[4];
    { const int r = C.lane & 31, hh = C.lane >> 5;
      const bf16* st = (const bf16*)(a.ws + WS_ST) + ((size_t)gu * GDV + 32 * w + r) * GDK + 4 * hh;
#pragma unroll
      for (int db = 0; db < 4; ++db)
#pragma unroll
          for (int g = 0; g < 4; ++g) { const v2u x = *(const v2u*)(st + 32 * db + 8 * g);
              S[db][4 * g] = bf2f(x.x & 0xffffu); S[db][4 * g + 1] = bf2f(x.x >> 16); S[db][4 * g + 2] = bf2f(x.y & 0xffffu); S[db][4 * g + 3] = bf2f(x.y >> 16); } }
    { LAS float* GW = (LAS float*)(C.lds + G3_GW);
#pragma unroll
      for (int k = 0; k < 4; ++k) { const int i = C.tid + 512 * k, rr = i >> 7, dd = i & 127; GW[i] = a.in[I_GW2][(size_t)l * GRANK * (GH * GDK) + rr * (GH * GDK) + h * GDK + dd]; }
      if (C.tid < 128) GW[16 * 128 + C.tid] = a.in[I_GB][l * (GH * GDK) + h * GDK + C.tid];
      if (C.tid >= 256) ((LAS float*)(C.lds + G3_NW))[C.tid - 256] = a.in[I_GNORM][(size_t)l * GDV + C.tid - 256];
      __syncthreads(); }
    v4u qq[2], kq[2]; unsigned glr;
#define G3_LOADQK(tt0, tid_) do { \
        glr = *(const unsigned*)(P + (size_t)((tt0) + ((tid_) >> 3)) * NIN + PC_GL + 2 * ((tid_) & 7)); \
        _Pragma("unroll") for (int i = 0; i < 2; ++i) { const int idx = (tid_) + 512 * i, c = idx >> 4, p16 = idx & 15; const bf16* row = P + (size_t)((tt0) + c) * NIN + h * GDK + 8 * p16; qq[i] = *(const v4u*)(row + PC_QG); kq[i] = *(const v4u*)(row + PC_KG); } } while (0)
    { int tid0_ = C.tid; asm volatile("" : "+v"(tid0_)); G3_LOADQK(b * SEQ + grp * GG * GCH, tid0_); }
#pragma unroll 1
    for (int j = 0; j < GG; ++j) {
        const int t0 = b * SEQ + (grp * GG + j) * GCH;
        int tid_ = C.tid; asm volatile("" : "+v"(tid_));
        Ctx C2 = C; C2.tid = tid_; C2.lane = tid_ & 63;
        const int lane = tid_ & 63, r = lane & 31, hh = lane >> 5, d = tid_ & 127, cg = tid_ >> 7;
        const int tq = (lane & 15) >> 2, tp = lane & 3, tblk = (lane >> 4) & 1;
        v4u vq[4], rq[4];
#pragma unroll
        for (int i = 0; i < 4; ++i) { const int idx = tid_ + 512 * i, c = idx >> 5, e8 = idx & 31; vq[i] = *(const v4u*)(P + (size_t)(t0 + c) * NIN + PC_VG + h * GDV + 8 * e8); }
        float bl[16], blast;
        gla_decay3(C2, a, glr, l, h, bl, blast);
#pragma unroll
        for (int i = 0; i < 2; ++i) { const int idx = tid_ + 512 * i, c = idx >> 4, p16 = idx & 15; *(LAS v4u*)(QT + c * G3_QROW + 16 * p16) = qq[i]; *(LAS v4u*)(KT + c * G3_QROW + 16 * p16) = kq[i]; }
        __syncthreads();
#pragma unroll
        for (int i = 0; i < 16; ++i) { LAS unsigned short* qp = (LAS unsigned short*)(QT + (16 * cg + i) * G3_QROW + 2 * d); LAS unsigned short* kp = (LAS unsigned short*)(KT + (16 * cg + i) * G3_QROW + 2 * d);
            const float kraw = bf2f(*kp);
            *qp = (unsigned short)f2bf(bf2f(*qp) * 0.08838834764831845f * __expf(bl[i])); *kp = (unsigned short)f2bf(kraw * __expf(-bl[i]));
            *(LAS unsigned short*)(KE + (16 * cg + i) * G3_KEROW + 2 * d) = (unsigned short)f2bf(kraw * __expf(blast - bl[i])); }
        if (cg == 0) DL[d] = __expf(blast);
#pragma unroll
        for (int i = 0; i < 4; ++i) { const int idx = tid_ + 512 * i, c = idx >> 5, e8 = idx & 31; *(LAS v4u*)(VR + c * 512 + ((16 * e8) ^ ((c & 3) << 6))) = vq[i]; }
        __syncthreads();
        { const bf16* rrow = P + (size_t)(t0 + (tid_ >> 3)) * NIN + PC_RG + h * GDV + 32 * (tid_ & 7);
#pragma unroll
          for (int i = 0; i < 4; ++i) rq[i] = *(const v4u*)(rrow + 8 * i); }
        f32x16 z[2];
#pragma unroll
        for (int i = 0; i < 16; ++i) { z[0][i] = 0.f; z[1][i] = 0.f; }
#pragma unroll
        for (int db = 0; db < 4; ++db)
#pragma unroll
            for (int st = 0; st < 2; ++st) { const bf16x8 sfr = pack8(S[db], st, 1.0f);
#pragma unroll
                for (int cb = 0; cb < 2; ++cb) { const LAS unsigned char* qp = QT + (32 * cb + r) * G3_QROW + (32 * db + 16 * st + 4 * hh) * 2;
                    const bf16x8 qf = cat8(*(const LAS s16x4*)qp, *(const LAS s16x4*)(qp + 16));
                    z[cb] = MFMA32(qf, sfr, z[cb]); } }
#pragma unroll
        for (int cb = 0; cb < 2; ++cb)
#pragma unroll
            for (int sb = 0; sb <= cb; ++sb) {
                f32x16 at;
#pragma unroll
                for (int i = 0; i < 16; ++i) at[i] = 0.f;
#pragma unroll
                for (int s = 0; s < 8; ++s) { const bf16x8 kf = *(const LAS bf16x8*)(KT + (32 * sb + r) * G3_QROW + (16 * s + 8 * hh) * 2), qf = *(const LAS bf16x8*)(QT + (32 * cb + r) * G3_QROW + (16 * s + 8 * hh) * 2); at = MFMA32(kf, qf, at); }
                if (sb == cb) {
#pragma unroll
                    for (int i = 0; i < 16; ++i) at[i] = (crow(i, hh) <= r) ? at[i] : 0.f; }
                if (sb == 0 && cb == 0 && grp == 0 && j == 0 && lane == 0) at[0] = a00;
#pragma unroll
                for (int st = 0; st < 2; ++st) { const bf16x8 pf = pack8(at, st, 1.0f);
                    const int c0 = 32 * sb + 16 * st + 4 * hh;
                    const LAS unsigned char* vp = VR + (c0 + tq) * 512 + ((64 * w + 32 * tblk + 8 * tp) ^ (tq << 6));
                    const bf16x8 vf = cat8(lds_tr16(vp), lds_tr16(vp + 8 * 512));
                    z[cb] = MFMA32(pf, vf, z[cb]); }
            }
        if (j + 1 < GG) {
#pragma unroll
            for (int db = 0; db < 4; ++db)
#pragma unroll
                for (int g = 0; g < 4; ++g) { const f32x4 dc = *(const LAS f32x4*)(DL + 32 * db + 8 * g + 4 * hh);
                    S[db][4 * g] *= dc.x; S[db][4 * g + 1] *= dc.y; S[db][4 * g + 2] *= dc.z; S[db][4 * g + 3] *= dc.w; }
#pragma unroll
            for (int s = 0; s < 4; ++s) { const int c0 = 16 * s + 8 * hh;
                const LAS unsigned char* vp = VR + (c0 + tq) * 512 + ((64 * w + 32 * tblk + 8 * tp) ^ (tq << 6));
                const bf16x8 vfr = cat8(lds_tr16(vp), lds_tr16(vp + 4 * 512));
#pragma unroll
                for (int db = 0; db < 4; ++db) { const LAS unsigned char* kp = KE + (c0 + tq) * G3_KEROW + 64 * db + 32 * tblk + 8 * tp;
                    const bf16x8 kfr = cat8(lds_tr16(kp), lds_tr16(kp + 4 * G3_KEROW));
                    S[db] = MFMA32(kfr, vfr, S[db]); } }
        }
        if (j + 1 < GG) G3_LOADQK(t0 + GCH, tid_);
        __syncthreads();
        LAS float* OT = (LAS float*)(C.lds + G3_QT);
#pragma unroll
        for (int cb = 0; cb < 2; ++cb)
#pragma unroll
            for (int i = 0; i < 16; ++i) OT[(32 * cb + crow(i, hh)) * G3_OROW + 32 * w + r] = z[cb][i];
        __syncthreads();
        { const int c = tid_ >> 3, es = tid_ & 7;
          const LAS f32x4* orow = (const LAS f32x4*)(OT + c * G3_OROW + 32 * es);
          f32x4 v[8]; float ss = 0.f;
#pragma unroll
          for (int i = 0; i < 8; ++i) { v[i] = orow[i]; ss += (v[i].x * v[i].x + v[i].y * v[i].y) + (v[i].z * v[i].z + v[i].w * v[i].w); }
          ss += shx(ss, 1, lane); ss += shx(ss, 2, lane); ss += shx(ss, 4, lane);
          const float rinv = 1.0f / sqrtf(ss * (1.0f / GDV) + EPS);
          const LAS float* nw = (const LAS float*)(C.lds + G3_NW) + 32 * es;
          bf16* orow_g = O + (size_t)(t0 + c) * D + D / 2 + h * GDV + 32 * es;
#pragma unroll
          for (int i = 0; i < 4; ++i) { const f32x4 w0 = *(const LAS f32x4*)(nw + 8 * i) * rinv, w1 = *(const LAS f32x4*)(nw + 8 * i + 4) * rinv;
              const f32x4 x0 = v[2 * i], x1 = v[2 * i + 1];
              const float r0 = bf2f(rq[i].x & 0xffffu), r1 = bf2f(rq[i].x >> 16), r2 = bf2f(rq[i].y & 0xffffu), r3 = bf2f(rq[i].y >> 16), r4 = bf2f(rq[i].z & 0xffffu), r5 = bf2f(rq[i].z >> 16), r6 = bf2f(rq[i].w & 0xffffu), r7 = bf2f(rq[i].w >> 16);
              v4u o; o.x = pk2(x0.x * w0.x * pg8::silu_f(r0), x0.y * w0.y * pg8::silu_f(r1)); o.y = pk2(x0.z * w0.z * pg8::silu_f(r2), x0.w * w0.w * pg8::silu_f(r3));
              o.z = pk2(x1.x * w1.x * pg8::silu_f(r4), x1.y * w1.y * pg8::silu_f(r5)); o.w = pk2(x1.z * w1.z * pg8::silu_f(r6), x1.w * w1.w * pg8::silu_f(r7));
              *(v4u*)(orow_g + 8 * i) = o; } }
        __syncthreads();
    }
}

#ifndef PROBE_MASK
#define PROBE_MASK 0
#endif
#define REP(bit) for (int rep_ = 0; rep_ < (((PROBE_MASK) >> (bit)) & 1) + 1; ++rep_)
#define FRESH_CTX(Cn) Ctx Cn = C; { int t_ = threadIdx.x, g_ = C.gw; asm volatile("" : "+v"(t_), "+s"(g_)); Cn.tid = t_; Cn.lane = t_ & 63; Cn.gw = g_; }
__global__ void __launch_bounds__(NWAVES * 64, 2) hybrid_fwd(Args args) {
    extern __shared__ __attribute__((aligned(16))) unsigned char lds[];
    Ctx C;
    C.lds = (LAS unsigned char*)lds;
    C.tid = threadIdx.x; C.lane = C.tid & 63; C.wave = __builtin_amdgcn_readfirstlane(C.tid >> 6);
    C.G = gridDim.x; { const int bx = blockIdx.x; const int vcu = (C.G % 8 == 0) ? (bx % 8) * (C.G / 8) + bx / 8 : bx; C.gw = vcu * NWAVES + C.wave; C.NGW = C.G * NWAVES; }
    volatile LAS unsigned* MISC = (volatile LAS unsigned*)(C.lds + MISC_OFF);
    unsigned char* ws = args.ws;
    gu32* ctl = (gu32*)(ws + WS_CTL);
    for (int u = C.tid; u < (LDS_BYTES - LDSCTL_OFF) / 4; u += NWAVES * 64) ((LAS unsigned*)(C.lds + LDSCTL_OFF))[u] = 0u;
    __syncthreads();
    XcdBarrier bar; bar.bar = (unsigned*)(ctl + CW_BAR); bar.x = 0; bar.st = nullptr;
    if (MK_N_LAUNCHES == 1) bar = xcd_barrier_post((unsigned*)(ctl + CW_BAR), MISC + 8);
    const int lo = args.ph_lo, hi = args.ph_hi;
#define IN(k) (lo <= (k) && (k) < hi)
#define SEAM(k) do { if (MK_N_LAUNCHES == 1) { if (IN((k) + 1)) xcd_barrier(bar); } } while (0)

    const float* modp = (const float*)(ws + WS_MOD); const float* fmodp = (const float*)(ws + WS_FMOD);
    bf16* U = (bf16*)(ws + WS_U); bf16* HID = (bf16*)(ws + WS_HID); bf16* P = (bf16*)(ws + WS_HID); bf16* OMIX = (bf16*)(ws + WS_OMIX); _Float16* HS = (_Float16*)(ws + WS_H); signed char* U8 = (signed char*)(ws + WS_U); float* SROW = (float*)(ws + WS_SROW);

    if (IN(0)) {
#ifndef DIS_P0MOD
 REP(0) { FRESH_CTX(Cp) p0_mod(Cp, args); }
#endif
 { FRESH_CTX(Cp) p0_phase_a(Cp, args, MISC + 16); }
 SEAM(0); }

#pragma unroll 1
    for (int l = 0; l < DEPTH; ++l) {
        const int pb = 1 + 12 * l;
        const float* modl = modp + (size_t)l * BATCH * NMOD * D;
        unsigned char* wl = ws + WS_W + (size_t)l * W_LAYER;
#pragma unroll 1
        for (int f = 0; f < 2; ++f) {
            const int pf = pb + (f ? 9 : 0), sub = f ? 2 : 0;
            if (IN(pf + 0)) {
                const float* src = (l == 0 && f == 0) ? args.in[I_X] : args.out;
#ifndef DIS_NORM
                if (l == 0 && f == 0) { REP(1) { FRESH_CTX(Cp) norm_q8<true>(Cp, args.in[I_X], args.in[I_NFFN1], modl + 0 * D, modl + 1 * D, NMOD * D, U8, SROW); } }
                else { REP(1) { FRESH_CTX(Cp) norm_q8<false>(Cp, HS, args.in[f ? I_NFFN2 : I_NFFN1] + (size_t)l * D, modl + (3 * sub + 0) * D, modl + (3 * sub + 1) * D, NMOD * D, U8, SROW); } }
#endif
                SEAM(pf + 0);
            }
            if (IN(pf + 1)) {
                pg8::Gemm g{(const bf16*)U8, (const bf16*)(wl + f * W_FFN), M, NUP, D / 2};
                pg8::StaticOrder S; S.init(M, NUP, C.G, (int)blockIdx.x);
                pg8::EpiSwiGLU8 E{HID, FF, SROW, (const float*)(ws + WS_SCOL) + (size_t)(l * 2 + f) * NUP};
#ifndef DIS_UP
                REP(2) pg8::gemm_phase<pg8::EpiSwiGLU8, pg8::StaticOrder, GEMM_ALIGN, GEMM_SP2>(C.lds + RING_OFF, g, S, E);
#endif
                SEAM(pf + 1);
            }
            if (IN(pf + 2)) {
                pg8::Gemm g{HID, (const bf16*)(wl + f * W_FFN + W_DN), M, D, FF}; DN_ORDER S; S.init(M, D, C.G, (int)blockIdx.x);
                if (l == 0 && f == 0) { pg8::EpiResidH<true, true> E{args.in[I_X], HS, modl + (3 * sub + 2) * D, D, NMOD * D};
                    pg8::gemm_phase<pg8::EpiResidH<true, true>, DN_ORDER, GEMM_ALIGN, GEMM_SP2>(C.lds + RING_OFF, g, S, E); }
                else { pg8::EpiResidH<false, true> E{HS, HS, modl + (3 * sub + 2) * D, D, NMOD * D};
                    pg8::gemm_phase<pg8::EpiResidH<false, true>, DN_ORDER, GEMM_ALIGN, GEMM_SP2>(C.lds + RING_OFF, g, S, E); }
                SEAM(pf + 2);
            }
            if (f == 0) {
                if (IN(pb + 3)) {
#ifndef DIS_NORM
                    REP(1) { FRESH_CTX(Cp) norm_phase_h<false>(Cp, HS, args.in[I_NMIX] + (size_t)l * D, modl + 3 * D, modl + 4 * D, NMOD * D, U, nullptr); }
                    { FRESH_CTX(Cp) tok0_row(Cp, args, HS, args.in[I_NMIX] + (size_t)l * D, modl + 3 * D, modl + 4 * D, NMOD * D); }
#endif
                    SEAM(pb + 3);
                }
                if (IN(pb + 4)) {
                    pg8::Gemm g{U, (const bf16*)(wl + W_IN), M, NIN, D}; pg8::StaticOrder S; S.init(M, NIN, C.G, (int)blockIdx.x);
                    pg8::EpiBf16 E{P, NIN};
#ifndef DIS_IN
                    REP(3) pg8::gemm_phase<pg8::EpiBf16, pg8::StaticOrder, GEMM_ALIGN, GEMM_SP2>(C.lds + RING_OFF, g, S, E);
#endif
                    SEAM(pb + 4);
                }
                if (IN(pb + 5)) {
                    #ifndef DIS_ATTN
                    { FRESH_CTX(Cp) tok0_qk_partial(Cp, args, l); }
                    REP(4) { FRESH_CTX(Cp) for (int u = blockIdx.x; u < BATCH * NBLK * NKV; u += C.G) attn_unit2(Cp, P, OMIX, args.in[I_SINK] + l * NQH, u); }
#endif
                    #ifndef DIS_G1
                    REP(5) { FRESH_CTX(Cp) for (int gu = blockIdx.x; gu < BATCH * NGRP * GH; gu += C.G) gla_g1_grp(Cp, args, P, l, gu); }
#endif
                    SEAM(pb + 5);
                }
                if (IN(pb + 6)) {
                    { FRESH_CTX(Cp) tok0_qk_reduce(Cp, args); }
#ifndef DIS_SCAN
 REP(6) { FRESH_CTX(Cp) gla_scan_grp(Cp, args); }
#endif
 SEAM(pb + 6); }
                if (IN(pb + 7)) {
                    #ifndef DIS_G3
                    REP(7) { FRESH_CTX(Cp) for (int gu = blockIdx.x; gu < BATCH * NGRP * GH; gu += C.G) gla_g3_grp(Cp, args, P, OMIX, l, gu); }
#endif
                    SEAM(pb + 7);
                }
                if (IN(pb + 8)) {
                    pg8::Gemm g{OMIX, (const bf16*)(wl + W_OUT), M, D, D}; pg8::StaticOrder S; S.init(M, D, C.G, (int)blockIdx.x);
                    pg8::EpiResidH<false, false> E{HS, HS, modl + 5 * D, D, NMOD * D};
                    pg8::gemm_phase<pg8::EpiResidH<false, false>, pg8::StaticOrder, GEMM_ALIGN, GEMM_SP2>(C.lds + RING_OFF, g, S, E);
                    SEAM(pb + 8);
                }
            }
        }
    }
#ifndef DIS_NORM
    if (IN(NPH - 1)) { FRESH_CTX(Cp) norm_phase_h<true>(Cp, HS, args.in[I_FNORM], fmodp, fmodp + D, 2 * D, nullptr, args.out); }
#endif
#ifdef PROBE_WAIT
    {
        if (threadIdx.x == 0) { const unsigned w = MISC[12]; atomicAdd((unsigned*)(ctl + 8192), w); atomicMax((unsigned*)(ctl + 8193), ~0u - w); atomicMax((unsigned*)(ctl + 8194), w); atomicAdd((unsigned*)(ctl + 8195), MISC[13]); if (blockIdx.x == 0) atomicAdd((unsigned*)(ctl + 8196), MISC[15]); }
        xcd_barrier(bar);
        if (threadIdx.x == 0) {
            const unsigned sum = __hip_atomic_load((unsigned*)(ctl + 8192), RLX_AGENT), mn = ~0u - __hip_atomic_load((unsigned*)(ctl + 8193), RLX_AGENT), mx = __hip_atomic_load((unsigned*)(ctl + 8194), RLX_AGENT);
            const unsigned v = PROBE_WSEL == 0 ? sum / gridDim.x : PROBE_WSEL == 1 ? mn : PROBE_WSEL == 2 ? mx : PROBE_WSEL == 3 ? __hip_atomic_load((unsigned*)(ctl + 8195), RLX_AGENT) / 8 : __hip_atomic_load((unsigned*)(ctl + 8196), RLX_AGENT);
            const unsigned long long t0 = wall_clock64();
            while (wall_clock64() - t0 < (unsigned long long)v * PROBE_WAIT) __builtin_amdgcn_s_sleep(8);
        }
        __syncthreads();
    }
#endif
#undef IN
#undef SEAM
}

extern "C" void kernel_launch(void* const* d_in, const int* in_sizes, int n_in, void* d_out, int out_size, void* d_ws, size_t ws_size, hipStream_t stream) {
    static int grid = 0;
    if (grid == 0) {
        if (n_in != 22 || in_sizes[0] != M * D || out_size != M * D || ws_size < WS_END) { fprintf(stderr, "kernel_launch: unexpected shapes (n_in %d, in0 %d, out %d, ws %zu); nothing launched\n", n_in, n_in > 0 ? in_sizes[0] : -1, out_size, ws_size); grid = -1; return; }
        int dev = 0, cus = 0, per_cu = 0;
        if (hipGetDevice(&dev) != hipSuccess || hipDeviceGetAttribute(&cus, hipDeviceAttributeMultiprocessorCount, dev) != hipSuccess) { grid = -1; return; }
        if (hipFuncSetAttribute((const void*)hybrid_fwd, hipFuncAttributeMaxDynamicSharedMemorySize, LDS_BYTES) != hipSuccess) { fprintf(stderr, "kernel_launch: hipFuncSetAttribute failed\n"); grid = -1; return; }
        if (hipOccupancyMaxActiveBlocksPerMultiprocessor(&per_cu, (const void*)hybrid_fwd, NWAVES * 64, LDS_BYTES) != hipSuccess || per_cu < 1) { fprintf(stderr, "kernel_launch: occupancy query says %d blocks per CU; nothing launched\n", per_cu); (void)hipGetLastError(); grid = -1; return; }
        grid = cus;
    }
    if (grid < 0) return;
    if (hipMemsetAsync((char*)d_ws + WS_CTL, 0, CTL_ZERO_BYTES, stream) != hipSuccess) return;
    Args a{};
    for (int i = 0; i < 22; ++i) a.in[i] = (const float*)d_in[i];
    a.out = (float*)d_out; a.ws = (unsigned char*)d_ws; a.li = 0; a.pad = 0;
    if (MK_N_LAUNCHES == 1) { a.ph_lo = 0; a.ph_hi = NPH; hipLaunchKernelGGL(hybrid_fwd, dim3(grid), dim3(NWAVES * 64), LDS_BYTES, stream, a); }
    else for (int p = 0; p < NPH; ++p) { a.ph_lo = p; a.ph_hi = p + 1; hipLaunchKernelGGL(hybrid_fwd, dim3(grid), dim3(NWAVES * 64), LDS_BYTES, stream, a); }
}
```
